# Optimizing an MI355X kernel written in HIP

```python
import math
import jax
import jax.numpy as jnp
from jax import lax
import numpy as np

D_MODEL = 2048
BATCH = 4
SEQ = 4096
DEPTH = 2

NORM_EPS = 1e-6
CONV_K = 4

ATTN_HEADS = 4
ATTN_QK_DIM = 64
ATTN_V_DIM = 2 * ATTN_QK_DIM
ATTN_WIDTH = ATTN_HEADS * ATTN_V_DIM
Q_BLOCK = 128
REL_BUCKETS = 32
REL_MAX_DIST = 128

GDN_HEADS = 6
GDN_DIM = 128
GDN_WIDTH = GDN_HEADS * GDN_DIM
GDN_CHUNK = 64

SSM_HEADS = 12
SSM_HEAD_DIM = 64
SSM_GROUPS = 2
SSM_STATE = 128
SSM_WIDTH = SSM_HEADS * SSM_HEAD_DIM
SSM_XBC = SSM_WIDTH + 2 * SSM_GROUPS * SSM_STATE
SSM_CHUNK = 128

MIX_WIDTH = ATTN_WIDTH + GDN_WIDTH + SSM_WIDTH
IN_SIZES = (ATTN_WIDTH, ATTN_WIDTH, ATTN_WIDTH,
            3 * GDN_WIDTH, GDN_WIDTH, GDN_HEADS, GDN_HEADS,
            SSM_WIDTH, SSM_XBC, SSM_HEADS)
D_IN = 3 * ATTN_WIDTH + 4 * GDN_WIDTH + 2 * GDN_HEADS + SSM_WIDTH + SSM_XBC + SSM_HEADS

D_FF = 5632
N_EXPERTS = 8
TOP_K = 2
D_FF_EXPERT = 5632

kernel_name = 'hybrid_diffattn_gdn_ssd_moe_trunk'


def rmsnorm(x, gain):
    xf = x.astype(jnp.float32)
    y = xf * lax.rsqrt(jnp.mean(xf * xf, axis=-1, keepdims=True) + NORM_EPS)
    return (y * gain.astype(jnp.float32)).astype(x.dtype)


def l2norm(x):
    return x * lax.rsqrt(jnp.sum(x * x, axis=-1, keepdims=True) + NORM_EPS)


def causal_dwconv(x, w):
    c = x.shape[-1]
    return lax.conv_general_dilated(x, w[:, None, :], window_strides=(1,), padding=[(CONV_K - 1, 0)],
                                    dimension_numbers=('NWC', 'WIO', 'NWC'), feature_group_count=c)


def swiglu(h, wg, wu, wd):
    return (jax.nn.silu(h @ wg) * (h @ wu)) @ wd


def split_in_proj(proj):
    pieces, start = [], 0
    for size in IN_SIZES:
        pieces.append(proj[..., start:start + size])
        start += size
    return pieces


def t5_bucket(n):
    max_exact = REL_BUCKETS // 2
    nf = jnp.maximum(n, max_exact).astype(jnp.float32)
    large = max_exact + (jnp.log(nf / max_exact) / math.log(REL_MAX_DIST / max_exact)
                         * (REL_BUCKETS - max_exact)).astype(jnp.int32)
    return jnp.where(n < max_exact, n, jnp.minimum(large, REL_BUCKETS - 1))


def diff_attention(q, k, v, q_gain, k_gain, lam, sub_gain, rel_bias, layer_idx):
    B, S, H, _, d = q.shape
    lam_init = 0.8 - 0.6 * math.exp(-0.3 * layer_idx)
    lam = lam.astype(jnp.float32)
    lam_full = jnp.exp(jnp.sum(lam[0] * lam[1])) - jnp.exp(jnp.sum(lam[2] * lam[3])) + lam_init
    q = rmsnorm(q, q_gain) * (d ** -0.5)
    k = rmsnorm(k, k_gain)
    n_blk = S // Q_BLOCK
    q_blocks = q.reshape(B, n_blk, Q_BLOCK, H, 2, d).swapaxes(0, 1)
    k_pos = jnp.arange(S, dtype=jnp.int32)
    table = rel_bias.astype(jnp.float32)

    def one_block(args):
        q_blk, blk = args
        q_pos = blk * Q_BLOCK + jnp.arange(Q_BLOCK, dtype=jnp.int32)
        rel = q_pos[:, None] - k_pos[None, :]
        bias = jnp.take(table, t5_bucket(jnp.maximum(rel, 0)), axis=0)
        bias = jnp.where((rel >= 0)[..., None], bias, -jnp.inf)
        logits = jnp.einsum('bqhmd,bkhmd->bhmqk', q_blk, k, preferred_element_type=jnp.float32)
        logits = logits + jnp.transpose(bias, (2, 0, 1))[None, :, None]
        p = jax.nn.softmax(logits, axis=-1)
        attn = p[:, :, 0] - lam_full * p[:, :, 1]
        return jnp.einsum('bhqk,bkhe->bqhe', attn.astype(v.dtype), v)

    o = lax.map(one_block, (q_blocks, jnp.arange(n_blk, dtype=jnp.int32)))
    o = o.swapaxes(0, 1).reshape(B, S, H, 2 * d)
    o = rmsnorm(o, sub_gain) * (1.0 - lam_init)
    return o.reshape(B, S, H * 2 * d)


def gated_deltanet(qkv, gate, beta_raw, a_raw, conv_w, A_log, dt_bias, o_gain):
    B, S, _ = qkv.shape
    H, D, C = GDN_HEADS, GDN_DIM, GDN_CHUNK
    N = S // C
    qkv = jax.nn.silu(causal_dwconv(qkv, conv_w)).astype(jnp.float32)
    q, k, v = [t.reshape(B, S, H, D) for t in jnp.split(qkv, 3, axis=-1)]
    q = l2norm(q) * (D ** -0.5)
    k = l2norm(k)
    beta = jax.nn.sigmoid(beta_raw.astype(jnp.float32))
    g = -jnp.exp(A_log.astype(jnp.float32)) * jax.nn.softplus(a_raw.astype(jnp.float32) + dt_bias.astype(jnp.float32))
    chv = lambda t: t.reshape(B, N, C, H, D).transpose(0, 3, 1, 2, 4)
    chs = lambda t: t.reshape(B, N, C, H).transpose(0, 3, 1, 2)
    q, k, v = chv(q), chv(k), chv(v)
    beta = chs(beta)
    gc = jnp.cumsum(chs(g), axis=-1)
    idx = jnp.arange(C)
    diff = gc[..., :, None] - gc[..., None, :]
    strict = idx[:, None] > idx[None, :]
    causal = idx[:, None] >= idx[None, :]
    kb = k * beta[..., None]
    A = jnp.einsum('bhncd,bhnsd->bhncs', kb, k) * jnp.exp(jnp.where(strict, diff, -jnp.inf))
    M = A + jnp.eye(C, dtype=jnp.float32)
    rhs = jnp.concatenate([v * beta[..., None], kb * jnp.exp(gc)[..., None]], axis=-1)
    sol = lax.linalg.triangular_solve(M, rhs, left_side=True, lower=True, unit_diagonal=True)
    u, w = sol[..., :D], sol[..., D:]
    qk = jnp.einsum('bhncd,bhnsd->bhncs', q, k) * jnp.exp(jnp.where(causal, diff, -jnp.inf))
    q_dec = q * jnp.exp(gc)[..., None]
    k_dec = k * jnp.exp(gc[..., -1:] - gc)[..., None]
    decay = jnp.exp(gc[..., -1])

    def step(state, xs):
        u_n, w_n, q_n, k_n, qk_n, d_n = xs
        v_new = u_n - jnp.einsum('bhcd,bhde->bhce', w_n, state)
        o_n = jnp.einsum('bhcd,bhde->bhce', q_n, state) + jnp.einsum('bhcs,bhse->bhce', qk_n, v_new)
        state = state * d_n[..., None, None] + jnp.einsum('bhcd,bhce->bhde', k_n, v_new)
        return state, o_n

    mv = lambda t: jnp.moveaxis(t, 2, 0)
    s0 = jnp.zeros((B, H, D, D), jnp.float32)
    _, o = lax.scan(step, s0, (mv(u), mv(w), mv(q_dec), mv(k_dec), mv(qk), mv(decay)))
    o = o.transpose(1, 0, 3, 2, 4).reshape(B, S, H, D)
    o = rmsnorm(o, o_gain) * jax.nn.silu(gate.astype(jnp.float32)).reshape(B, S, H, D)
    return o.reshape(B, S, GDN_WIDTH).astype(gate.dtype)


def mamba2_ssd(z, xbc, dt_raw, conv_w, conv_b, A_log, dt_bias, D_skip, norm_gain):
    B, S, _ = xbc.shape
    G, R, P, Ns, L = SSM_GROUPS, SSM_HEADS // SSM_GROUPS, SSM_HEAD_DIM, SSM_STATE, SSM_CHUNK
    Nc = S // L
    xbc = jax.nn.silu(causal_dwconv(xbc, conv_w) + conv_b).astype(jnp.float32)
    x, Bm, Cm = jnp.split(xbc, [SSM_WIDTH, SSM_WIDTH + G * Ns], axis=-1)
    x = x.reshape(B, Nc, L, G, R, P)
    Bm = Bm.reshape(B, Nc, L, G, Ns)
    Cm = Cm.reshape(B, Nc, L, G, Ns)
    dt = jax.nn.softplus(dt_raw.astype(jnp.float32) + dt_bias.astype(jnp.float32)).reshape(B, Nc, L, G, R)
    A = -jnp.exp(A_log.astype(jnp.float32)).reshape(G, R)
    X = x * dt[..., None]
    Acum = jnp.cumsum(A * dt, axis=2)
    At = Acum.transpose(0, 1, 3, 4, 2)
    tril = jnp.arange(L)[:, None] >= jnp.arange(L)[None, :]
    Lmat = jnp.exp(jnp.where(tril, At[..., :, None] - At[..., None, :], -jnp.inf))
    CB = jnp.einsum('bclgn,bcsgn->bcgls', Cm, Bm)
    y_diag = jnp.einsum('bcgls,bcgrls,bcsgrp->bclgrp', CB, Lmat, X)
    decay_states = jnp.exp(Acum[:, :, -1:] - Acum)
    states = jnp.einsum('bclgn,bclgr,bclgrp->bcgrpn', Bm, decay_states, X)
    chunk_decay = jnp.exp(Acum[:, :, -1])

    def step(h, xs):
        st, d = xs
        return h * d[..., None, None] + st, h

    h0 = jnp.zeros((B, G, R, P, Ns), jnp.float32)
    _, prev = lax.scan(step, h0, (jnp.moveaxis(states, 1, 0), jnp.moveaxis(chunk_decay, 1, 0)))
    prev = jnp.moveaxis(prev, 0, 1)
    y_off = jnp.einsum('bclgn,bcgrpn,bclgr->bclgrp', Cm, prev, jnp.exp(Acum))
    y = y_diag + y_off + D_skip.astype(jnp.float32).reshape(G, R)[..., None] * x
    y = y.reshape(B, S, SSM_WIDTH) * jax.nn.silu(z.astype(jnp.float32))
    y = rmsnorm(y.reshape(B, S, G, SSM_WIDTH // G), norm_gain.reshape(G, SSM_WIDTH // G))
    return y.reshape(B, S, SSM_WIDTH).astype(z.dtype)


def moe_swiglu(h, router, wg, wu, wd):
    logits = (h @ router).astype(jnp.float32)
    top_vals, top_idx = lax.top_k(logits, TOP_K)
    top_w = jax.nn.softmax(top_vals, axis=-1)
    gates = jnp.sum(jax.nn.one_hot(top_idx, N_EXPERTS, dtype=jnp.float32) * top_w[..., None], axis=-2)
    y = jnp.zeros_like(h)
    for e in range(N_EXPERTS):
        y = y + gates[..., e:e + 1].astype(h.dtype) * swiglu(h, wg[e], wu[e], wd[e])
    return y


def setup_inputs(seed: int = 0) -> dict:
    key = jax.random.key(seed)
    ks = iter(jax.random.split(key, 32))
    f32 = jnp.float32
    n_dense = (DEPTH + 1) // 2
    n_moe = DEPTH // 2

    def normal(shape, scale):
        return jax.random.normal(next(ks), shape, f32) * scale

    def gain(shape):
        return 1.0 + normal(shape, 0.02)

    def a_log(shape):
        return jnp.log(jax.random.uniform(next(ks), shape, f32, 1.0, 16.0))

    def dt_bias(shape):
        dt = jnp.exp(jax.random.uniform(next(ks), shape, f32, math.log(1e-3), math.log(1e-1)))
        return dt + jnp.log(-jnp.expm1(-dt))

    return {
        'x': normal((BATCH, SEQ, D_MODEL), 1.0),
        'rel_bias': normal((REL_BUCKETS, ATTN_HEADS), 0.5),
        'mix_norm': gain((DEPTH, D_MODEL)),
        'w_in': normal((DEPTH, D_MODEL, D_IN), D_MODEL ** -0.5),
        'attn_q_gain': gain((DEPTH, ATTN_QK_DIM)),
        'attn_k_gain': gain((DEPTH, ATTN_QK_DIM)),
        'attn_lambda': normal((DEPTH, 4, ATTN_QK_DIM), 0.1),
        'attn_sub_gain': gain((DEPTH, ATTN_V_DIM)),
        'gdn_conv_w': normal((DEPTH, CONV_K, 3 * GDN_WIDTH), CONV_K ** -0.5),
        'gdn_A_log': a_log((DEPTH, GDN_HEADS)),
        'gdn_dt_bias': dt_bias((DEPTH, GDN_HEADS)),
        'gdn_o_gain': gain((DEPTH, GDN_DIM)),
        'ssm_conv_w': normal((DEPTH, CONV_K, SSM_XBC), CONV_K ** -0.5),
        'ssm_conv_b': normal((DEPTH, SSM_XBC), 0.02),
        'ssm_A_log': a_log((DEPTH, SSM_HEADS)),
        'ssm_dt_bias': dt_bias((DEPTH, SSM_HEADS)),
        'ssm_D': gain((DEPTH, SSM_HEADS)),
        'ssm_norm_gain': gain((DEPTH, SSM_WIDTH)),
        'w_out': normal((DEPTH, MIX_WIDTH, D_MODEL), MIX_WIDTH ** -0.5),
        'ffn_norm': gain((DEPTH, D_MODEL)),
        'ffn_w_gate': normal((n_dense, D_MODEL, D_FF), D_MODEL ** -0.5),
        'ffn_w_up': normal((n_dense, D_MODEL, D_FF), D_MODEL ** -0.5),
        'ffn_w_down': normal((n_dense, D_FF, D_MODEL), D_FF ** -0.5),
        'moe_router': normal((n_moe, D_MODEL, N_EXPERTS), D_MODEL ** -0.5),
        'moe_w_gate': normal((n_moe, N_EXPERTS, D_MODEL, D_FF_EXPERT), D_MODEL ** -0.5),
        'moe_w_up': normal((n_moe, N_EXPERTS, D_MODEL, D_FF_EXPERT), D_MODEL ** -0.5),
        'moe_w_down': normal((n_moe, N_EXPERTS, D_FF_EXPERT, D_MODEL), D_FF_EXPERT ** -0.5),
    }


def reference(x, rel_bias, mix_norm, w_in, attn_q_gain, attn_k_gain, attn_lambda, attn_sub_gain,
              gdn_conv_w, gdn_A_log, gdn_dt_bias, gdn_o_gain, ssm_conv_w, ssm_conv_b, ssm_A_log,
              ssm_dt_bias, ssm_D, ssm_norm_gain, w_out, ffn_norm, ffn_w_gate, ffn_w_up, ffn_w_down,
              moe_router, moe_w_gate, moe_w_up, moe_w_down):
    B, S, _ = x.shape
    for li in range(DEPTH):
        h = rmsnorm(x, mix_norm[li])
        aq, ak, av, g_qkv, g_gate, g_beta, g_a, s_z, s_xbc, s_dt = split_in_proj(h @ w_in[li])
        attn_o = diff_attention(aq.reshape(B, S, ATTN_HEADS, 2, ATTN_QK_DIM),
                                ak.reshape(B, S, ATTN_HEADS, 2, ATTN_QK_DIM),
                                av.reshape(B, S, ATTN_HEADS, ATTN_V_DIM),
                                attn_q_gain[li], attn_k_gain[li], attn_lambda[li], attn_sub_gain[li],
                                rel_bias, li)
        gdn_o = gated_deltanet(g_qkv, g_gate, g_beta, g_a, gdn_conv_w[li], gdn_A_log[li],
                               gdn_dt_bias[li], gdn_o_gain[li])
        ssm_o = mamba2_ssd(s_z, s_xbc, s_dt, ssm_conv_w[li], ssm_conv_b[li], ssm_A_log[li],
                           ssm_dt_bias[li], ssm_D[li], ssm_norm_gain[li])
        x = x + jnp.concatenate([attn_o, gdn_o, ssm_o], axis=-1) @ w_out[li]
        h = rmsnorm(x, ffn_norm[li])
        j = li // 2
        if li % 2 == 0:
            x = x + swiglu(h, ffn_w_gate[j], ffn_w_up[j], ffn_w_down[j])
        else:
            x = x + moe_swiglu(h, moe_router[j], moe_w_gate[j], moe_w_up[j], moe_w_down[j])
    return x
```

```cpp
#include <hip/hip_runtime.h>
#include <cstdio>
#include <cstdint>

#define LAS __attribute__((address_space(3)))
#define GAS __attribute__((address_space(1)))
typedef unsigned short bf16;
typedef short bf16x8 __attribute__((ext_vector_type(8)));
typedef short s16x4 __attribute__((ext_vector_type(4)));
typedef float f32x4 __attribute__((ext_vector_type(4)));
typedef float f32x2 __attribute__((ext_vector_type(2)));
typedef unsigned u32x4 __attribute__((ext_vector_type(4)));
typedef unsigned u32x2 __attribute__((ext_vector_type(2)));
typedef GAS unsigned gu32;
typedef GAS unsigned short gbf;
typedef GAS float gf32;
typedef GAS int gi32;

constexpr int BATCH = 4, SEQ = 4096, M = BATCH * SEQ, D = 2048, DIN = 6680, NPJ = 6912, DFF = 5632, NE = 8;
constexpr int AH = 4, AW = 512;
constexpr int GH = 6, GD = 128, GW = 768, GC = 64;
constexpr int SH = 12, SP = 64, SG = 2, SN = 128, SW = 768, SXBC = 1280, SL = 128;
constexpr float NORM_EPS = 1e-6f;
constexpr int PC_AQ = 0, PC_AK = 512, PC_AV = 1024, PC_GQKV = 1536, PC_GGATE = 3840, PC_SZ = 4608, PC_SXBC = 5376, PC_SMALL = 6656;

constexpr size_t MiB = 1u << 20;
constexpr size_t WS_CTL = 0, CTL_ZERO_BYTES = 1 * MiB;
constexpr size_t SZ_WIN = (size_t)NPJ * D * 2, SZ_WOUT = (size_t)D * D * 2, SZ_WGU = (size_t)2 * DFF * D * 2, SZ_WDN = (size_t)D * DFF * 2;
constexpr size_t WS_WIN = 2 * MiB;
constexpr size_t WS_WOUT = WS_WIN + 2 * SZ_WIN;
constexpr size_t WS_WGU = WS_WOUT + 2 * SZ_WOUT;
constexpr size_t WS_WDN = WS_WGU + SZ_WGU;
constexpr size_t WS_MGU = WS_WDN + SZ_WDN;
constexpr size_t WS_MDN = WS_MGU + NE * SZ_WGU;
constexpr size_t WS_H = WS_MDN + NE * SZ_WDN;
constexpr size_t WS_SMALL = WS_H + (size_t)M * D * 2;
constexpr size_t WS_ROUTE = WS_SMALL + (size_t)M * 32 * 4;
constexpr size_t WS_BIG = WS_ROUTE + 2 * MiB;
constexpr size_t WS_PROJ = WS_BIG;
constexpr size_t WS_MIX = WS_PROJ + (size_t)M * NPJ * 2;
constexpr size_t WS_SCR = WS_MIX + (size_t)M * D * 2;
constexpr size_t WS_ACT = WS_BIG;
constexpr size_t WS_HG = WS_BIG;
constexpr size_t WS_ACTM = WS_HG + (size_t)(2 * M + 256) * D * 2;
constexpr size_t WS_END_MOE = WS_ACTM + (size_t)(2 * M + 256) * DFF * 2;

constexpr size_t RT_TOKE = 0;
constexpr size_t RT_TOKW = RT_TOKE + M * 4;
constexpr size_t RT_WGCNT = RT_TOKW + M * 8;
constexpr size_t RT_STOK = RT_WGCNT + 1024 * 8 * 4;
constexpr size_t RT_SW = RT_STOK + (2 * M + 256) * 4;
constexpr size_t RT_TAB = RT_SW + (2 * M + 256) * 4;
constexpr size_t RT_TABD = RT_TAB + 4096;
constexpr size_t RT_TPOS = RT_TABD + 4096;
static_assert(RT_TPOS + M * 8 <= 2 * MiB, "route tables");

constexpr int CW_TMO = 0, CW_CODE = 1, CW_BAR = 4096, CW_QUEUE = 16384;

constexpr int RING_BYTES = 143360;
constexpr int LDSCTL_OFF = RING_BYTES, MISC_OFF = LDSCTL_OFF + 256;
constexpr int LDS_BYTES = 147456;

constexpr int NWAVES = 8, NTHR = 512;

#define RLX_AGENT __ATOMIC_RELAXED, __HIP_MEMORY_SCOPE_AGENT
#define LDS_WAIT() asm volatile("s_waitcnt lgkmcnt(0)" ::: "memory")
#define VM_WAIT() asm volatile("s_waitcnt vmcnt(0)" ::: "memory")
__device__ __forceinline__ float bf2f(unsigned short b) { return __uint_as_float(((unsigned)b) << 16); }
__device__ __forceinline__ float bflo(unsigned w) { return __uint_as_float(w << 16); }
__device__ __forceinline__ float bfhi(unsigned w) { return __uint_as_float(w & 0xffff0000u); }
typedef __bf16 bf16x2_t __attribute__((ext_vector_type(2)));
__device__ __forceinline__ unsigned pk2(float lo, float hi) { f32x2 v = {lo, hi}; bf16x2_t b = __builtin_convertvector(v, bf16x2_t); return __builtin_bit_cast(unsigned, b); }
__device__ __forceinline__ unsigned short f2bf(float f) { return (unsigned short)(pk2(f, 0.f) & 0xffffu); }
__device__ __forceinline__ float shfl_xor_l(float v, int o, int lane) { return __builtin_bit_cast(float, __builtin_amdgcn_ds_bpermute((lane ^ o) << 2, __builtin_bit_cast(int, v))); }
__device__ __forceinline__ unsigned pk4_fp8(float a, float b, float c, float d) {
#if defined(__HIP_DEVICE_COMPILE__)
    int w = __builtin_amdgcn_cvt_pk_fp8_f32(a, b, 0, false); w = __builtin_amdgcn_cvt_pk_fp8_f32(c, d, w, true); return (unsigned)w;
#else
    return 0u;
#endif
}
__device__ __forceinline__ float sat8(float x) { return __builtin_fminf(__builtin_fmaxf(x, -448.0f), 448.0f); }
__device__ __forceinline__ unsigned pk4_fp8_sat(float a, float b, float c, float d) { return pk4_fp8(sat8(a), sat8(b), sat8(c), sat8(d)); }
typedef int v8i32 __attribute__((ext_vector_type(8)));
typedef int v4i32 __attribute__((ext_vector_type(4)));
#ifndef DENSE_GU_F8
#define DENSE_GU_F8 1
#endif
constexpr float W8_SCALE = 64.0f, ACT8_SCALE = 8.0f;
constexpr int SC_ONE = 0x7f7f7f7f, SC_W8 = 0x79797979, SC_ACT8 = 0x7c7c7c7c;
__device__ __forceinline__ float wave_sum(float v, int lane) {
#pragma unroll
    for (int o = 1; o < 64; o <<= 1) v += shfl_xor_l(v, o, lane);
    return v;
}
__device__ __forceinline__ float fast_exp2(float x) { return __builtin_amdgcn_exp2f(x); }
__device__ __forceinline__ float fast_rcp(float x) { return __builtin_amdgcn_rcpf(x); }
__device__ __forceinline__ float silu_f(float g) { return g * fast_rcp(1.0f + fast_exp2(-1.4426950408889634f * g)); }
__device__ __forceinline__ float sigmoid_f(float g) { return 1.0f / (1.0f + __expf(-g)); }
__device__ __forceinline__ float softplus_f(float x) { const float e = __expf(x); return x > 15.f ? x : (e < 4.0e-4f ? e * (1.0f - 0.5f * e) : __logf(1.0f + e)); }

__device__ __forceinline__ void gatomic_add(gf32* p, float v) {
#if defined(__HIP_DEVICE_COMPILE__)
    (void)__builtin_amdgcn_global_atomic_fadd_f32(p, v);
#endif
}
namespace pg8 {
constexpr int BM = 256, BK = 64, HALF = 128, HTB = HALF * BK * 2, STAGE_BYTES = 8 * HTB, NXCD = 8, WGM = 8;
__host__ __device__ __forceinline__ int lds_byte(int r, int c) { const int st = (r >> 4) * 2 + (c >> 5), rr = r & 15, cc = c & 31, ob = rr * 64 + cc * 2; return st * 1024 + (ob ^ (((ob >> 9) & 1) << 5)); }
__host__ __device__ __forceinline__ void stage_rc(int b, int& R, int& C) { const int st = b / 1024, sb = b % 1024, swz = sb ^ (((sb >> 9) & 1) << 5); R = (st >> 1) * 16 + swz / 64; C = (st & 1) * 32 + (swz % 64) / 2; }
__host__ __device__ __forceinline__ int perm32(int rho) { const int n = rho >> 4, i = rho & 15; return 8 * (i >> 2) + 4 * n + (i & 3); }

struct Unit { int arow, brow, pn, nvalid; };
struct Gemm { const gbf* A; const gbf* Bt; int K; int sca, scb; };

struct StaticOrder {
    int nM, nN, nwg, G, c;
    __device__ void init(int Mr, int N, int G_, int c_) { nM = Mr / BM; nN = N / BM; nwg = nM * nN; G = G_; c = c_; }
    __device__ bool next(int i, Unit& u) const {
        const long L = (long)i * G + c; if (L >= nwg) return false;
        int wgid = (int)L; { const int q = nwg / NXCD, r = nwg % NXCD, xcd = wgid % NXCD, off = wgid / NXCD; wgid = (xcd < r ? xcd * (q + 1) : r * (q + 1) + (xcd - r) * q) + off; }
        const int nig = WGM * nN, gid = wgid / nig, fm = gid * WGM, gsz = (nM - fm) < WGM ? (nM - fm) : WGM;
        const int pm = fm + ((wgid % nig) % gsz), pn = (wgid % nig) / gsz;
        u.arow = pm * BM; u.brow = pn * BM; u.pn = pn; u.nvalid = BM; return true;
    }
};
struct MoeOrder {
    const gi32* tab; int nN, G, c, nexp_rows;
    __device__ bool next(int i, Unit& u) const {
        const int nM = tab[0]; const int nwg = nM * nN;
        const long L = (long)i * G + c; if (L >= nwg) return false;
        int wgid = (int)L; { const int q = nwg / NXCD, r = nwg % NXCD, xcd = wgid % NXCD, off = wgid / NXCD; wgid = (xcd < r ? xcd * (q + 1) : r * (q + 1) + (xcd - r) * q) + off; }
        const int nig = WGM * nN, gid = wgid / nig, fm = gid * WGM, gsz = (nM - fm) < WGM ? (nM - fm) : WGM;
        const int pm = fm + ((wgid % nig) % gsz), pn = (wgid % nig) / gsz;
        const int e = tab[4 + 4 * pm];
        u.arow = tab[5 + 4 * pm]; u.brow = e * nexp_rows + pn * BM; u.pn = pn; u.nvalid = tab[6 + 4 * pm]; return true;
    }
};

struct EpiProj {
    static constexpr bool PERM = true;
    gbf* O; gf32* small;
    __device__ __forceinline__ void operator()(const f32x4 (&acc)[2][2][4][2], const Unit& u, int wr, int wc, int fr, int fq) const {
        const int row0 = u.arow + wr * 64 + fr;
        if (u.pn < 26) {
            const int col0 = u.pn * BM + wc * 32 + 8 * fq;
#pragma unroll
            for (int ai = 0; ai < 2; ++ai)
#pragma unroll
                for (int m = 0; m < 4; ++m) { gbf* rowp = O + (size_t)(row0 + ai * HALF + m * 16) * NPJ + col0;
#pragma unroll
                    for (int bj = 0; bj < 2; ++bj) { const f32x4 v0 = acc[ai][bj][m][0], v1 = acc[ai][bj][m][1];
                        u32x4 w; w.x = pk2(v0[0], v0[1]); w.y = pk2(v0[2], v0[3]); w.z = pk2(v1[0], v1[1]); w.w = pk2(v1[2], v1[3]);
                        *(GAS u32x4*)(rowp + bj * HALF) = w; } }
        } else if (wc == 0) {
#pragma unroll
            for (int ai = 0; ai < 2; ++ai)
#pragma unroll
                for (int m = 0; m < 4; ++m) { gf32* rowp = small + (size_t)(row0 + ai * HALF + m * 16) * 32 + 8 * fq;
                    *(GAS f32x4*)(rowp) = acc[ai][0][m][0]; *(GAS f32x4*)(rowp + 4) = acc[ai][0][m][1]; }
        }
    }
};
struct EpiResF32 {
    static constexpr bool PERM = false;
    const gf32* res; gf32* out; int ldc;
    __device__ __forceinline__ void operator()(const f32x4 (&acc)[2][2][4][2], const Unit& u, int wr, int wc, int fr, int fq) const {
        const int row0 = u.arow + wr * 64 + fr, col0 = u.pn * BM + wc * 32 + 4 * fq;
#pragma unroll
        for (int ai = 0; ai < 2; ++ai)
#pragma unroll
            for (int m = 0; m < 4; ++m) { const size_t off = (size_t)(row0 + ai * HALF + m * 16) * ldc + col0;
#pragma unroll
                for (int bj = 0; bj < 2; ++bj)
#pragma unroll
                    for (int n = 0; n < 2; ++n) { const f32x4 r = *(const GAS f32x4*)(res + off + bj * HALF + n * 16); *(GAS f32x4*)(out + off + bj * HALF + n * 16) = r + acc[ai][bj][m][n]; }
                asm volatile("" ::: "memory"); }
    }
};
template <bool F8> struct EpiSwiglu {
    static constexpr bool PERM = true;
    gbf* O; const gf32* sw;
    __device__ __forceinline__ void operator()(const f32x4 (&acc)[2][2][4][2], const Unit& u, int wr, int wc, int fr, int fq) const {
        const int lr0 = wr * 64 + fr, col0 = u.pn * HALF + wc * 32 + 8 * fq;
#pragma unroll
        for (int ai = 0; ai < 2; ++ai)
#pragma unroll
            for (int m = 0; m < 4; ++m) { const int lr = lr0 + ai * HALF + m * 16;
                if (lr < u.nvalid) {
                    const float s = (sw ? sw[u.arow + lr] : 1.0f) * (F8 ? ACT8_SCALE : 1.0f);
                    const f32x4 g0 = acc[ai][0][m][0], g1 = acc[ai][0][m][1], u0 = acc[ai][1][m][0], u1 = acc[ai][1][m][1];
                    float a[8];
#pragma unroll
                    for (int j = 0; j < 4; ++j) { a[j] = silu_f(g0[j]) * u0[j] * s; a[4 + j] = silu_f(g1[j]) * u1[j] * s; }
                    if (F8) { u32x2 w; w.x = pk4_fp8_sat(a[0], a[1], a[2], a[3]); w.y = pk4_fp8_sat(a[4], a[5], a[6], a[7]);
                        *(GAS u32x2*)((GAS unsigned char*)O + (size_t)(u.arow + lr) * DFF + col0) = w; }
                    else { u32x4 w; w.x = pk2(a[0], a[1]); w.y = pk2(a[2], a[3]); w.z = pk2(a[4], a[5]); w.w = pk2(a[6], a[7]);
                        *(GAS u32x4*)(O + (size_t)(u.arow + lr) * DFF + col0) = w; } }
                asm volatile("" ::: "memory"); }
    }
};
struct EpiDown {
    static constexpr bool PERM = false;
    gf32* out; gbf* Y;
    __device__ __forceinline__ void operator()(const f32x4 (&acc)[2][2][4][2], const Unit& u, int wr, int wc, int fr, int fq) const {
        const int lr0 = wr * 64 + fr, col0 = u.pn * BM + wc * 32 + 4 * fq;
#pragma unroll
        for (int ai = 0; ai < 2; ++ai)
#pragma unroll
            for (int m = 0; m < 4; ++m) { const int lr = lr0 + ai * HALF + m * 16;
                if (lr < u.nvalid) {
                    if (Y) { gbf* rowp = Y + (size_t)(u.arow + lr) * D + col0;
#pragma unroll
                        for (int bj = 0; bj < 2; ++bj)
#pragma unroll
                            for (int n = 0; n < 2; ++n) { const f32x4 v = acc[ai][bj][m][n]; u32x2 o; o.x = pk2(v[0], v[1]); o.y = pk2(v[2], v[3]); *(GAS u32x2*)(rowp + bj * HALF + n * 16) = o; }
                    } else { gf32* rowp = out + (size_t)(u.arow + lr) * D + col0;
#pragma unroll
                        for (int bj = 0; bj < 2; ++bj)
#pragma unroll
                            for (int n = 0; n < 2; ++n) { const f32x4 r = *(const GAS f32x4*)(rowp + bj * HALF + n * 16); *(GAS f32x4*)(rowp + bj * HALF + n * 16) = r + acc[ai][bj][m][n]; }
                    } }
                asm volatile("" ::: "memory"); }
    }
};

template <class Epi, class Sched, bool FP8 = false, bool ALIGN_EPI = true>
__device__ __forceinline__ void gemm_phase(LAS unsigned char* lds, const Gemm g, const Sched& S, const Epi& E, const int tid) {
    const int wid = __builtin_amdgcn_readfirstlane(tid >> 6), lane = tid & 63, wr = wid >> 2, wc = wid & 3, fr = lane & 15, fq = lane >> 4;
    const int K = g.K, rowb = FP8 ? K : 2 * K, nt = rowb / 128;
    unsigned voffA[2], voffB[2];
#pragma unroll
    for (int i = 0; i < 2; ++i) { int R, C; stage_rc(tid * 16 + i * 8192, R, C); const int Rb = Epi::PERM ? ((R & ~31) + perm32(R & 31)) : R;
        voffA[i] = (unsigned)(R * rowb + C * 2); voffB[i] = (unsigned)(Rb * rowb + C * 2); }
    const size_t kstep = (size_t)(BK * 2);
    const size_t hstep = (size_t)HALF * rowb;
    const size_t rstep = (size_t)rowb;
    const unsigned ldsw = (unsigned)wid * 1024u;
    const int aoff = lds_byte(wr * 64 + fr, fq * 8), boff = lds_byte(wc * 32 + fr, fq * 8);
    const int cL = (fq >> 1) * 32 + (2 * (fq & 1)) * 8, cH = cL + 8;
    const int aoffL = lds_byte(wr * 64 + fr, cL), aoffH = lds_byte(wr * 64 + fr, cH), boffL = lds_byte(wc * 32 + fr, cL), boffH = lds_byte(wc * 32 + fr, cH);
#define PG8_SA(b, h) (((b) * 2 + (h)) * HTB)
#define PG8_SB(b, h) ((4 + (b) * 2 + (h)) * HTB)
#define PG8_STAGE(bufoff, gbase, voff) do { _Pragma("unroll") for (int _i = 0; _i < 2; ++_i) \
        __builtin_amdgcn_global_load_lds((const unsigned*)((const char*)(gbase) + (voff)[_i]), (LAS unsigned*)(lds + (bufoff) + ldsw + _i * 8192), 16, 0, 0); } while (0)
#define PG8_LD2(p0, p1) ({ const v4i32 l_ = *(const LAS v4i32*)(p0), h_ = *(const LAS v4i32*)(p1); __builtin_shufflevector(l_, h_, 0, 1, 2, 3, 4, 5, 6, 7); })
#define PG8_LDA(dst, b, h) do { _Pragma("unroll") for (int m = 0; m < 4; ++m) dst[m] = FP8 ? PG8_LD2(lds + PG8_SA(b, h) + aoffL + m * 2048, lds + PG8_SA(b, h) + aoffH + m * 2048) \
        : PG8_LD2(lds + PG8_SA(b, h) + aoff + m * 2048, lds + PG8_SA(b, h) + aoff + m * 2048 + 1024); } while (0)
#define PG8_LDB(dst, b, h) do { _Pragma("unroll") for (int n = 0; n < 2; ++n) dst[n] = FP8 ? PG8_LD2(lds + PG8_SB(b, h) + boffL + n * 2048, lds + PG8_SB(b, h) + boffH + n * 2048) \
        : PG8_LD2(lds + PG8_SB(b, h) + boff + n * 2048, lds + PG8_SB(b, h) + boff + n * 2048 + 1024); } while (0)
#define PG8_LO(x) __builtin_bit_cast(bf16x8, __builtin_shufflevector((x), (x), 0, 1, 2, 3))
#define PG8_HI(x) __builtin_bit_cast(bf16x8, __builtin_shufflevector((x), (x), 4, 5, 6, 7))
#define PG8_MMA(ai, bj, At, Bt) do { __builtin_amdgcn_s_setprio(1); _Pragma("unroll") for (int m = 0; m < 4; ++m) _Pragma("unroll") for (int n = 0; n < 2; ++n) { \
        if (FP8) asm volatile("v_mfma_scale_f32_16x16x128_f8f6f4 %0, %1, %2, %0, %3, %4 op_sel_hi:[0,0,0]" : "+v"(acc[ai][bj][m][n]) : "v"(Bt[n]), "v"(At[m]), "v"(scb_v), "v"(sca_v));   \
        else { acc[ai][bj][m][n] = __builtin_amdgcn_mfma_f32_16x16x32_bf16(PG8_LO(Bt[n]), PG8_LO(At[m]), acc[ai][bj][m][n], 0, 0, 0); \
               acc[ai][bj][m][n] = __builtin_amdgcn_mfma_f32_16x16x32_bf16(PG8_HI(Bt[n]), PG8_HI(At[m]), acc[ai][bj][m][n], 0, 0, 0); } } \
        __builtin_amdgcn_s_setprio(0); } while (0)
#define PG8_WAIT_V(n) asm volatile("s_waitcnt vmcnt(" #n ")" ::: "memory")
#define PG8_WAIT_L(n) asm volatile("s_waitcnt lgkmcnt(" #n ")" ::: "memory")
#define PG8_BAR __builtin_amdgcn_s_barrier()
#define PG8_SCHED __builtin_amdgcn_sched_barrier(0)
    Unit cur, nxt; int ui = 0;
    if (!S.next(0, cur)) return;
    f32x4 acc[2][2][4][2];
#pragma unroll
    for (int a = 0; a < 2; ++a)
#pragma unroll
        for (int b = 0; b < 2; ++b)
#pragma unroll
            for (int m = 0; m < 4; ++m)
#pragma unroll
                for (int n = 0; n < 2; ++n) acc[a][b][m][n] = (f32x4){0.f, 0.f, 0.f, 0.f};
    v8i32 At[4], B0[2], B1[2];
    const int sca_v = g.sca, scb_v = g.scb;
    const char* cA = (const char*)g.A + (size_t)cur.arow * rstep; const char* cB = (const char*)g.Bt + (size_t)cur.brow * rstep;
    PG8_STAGE(PG8_SB(0, 0), cB, voffB); PG8_STAGE(PG8_SB(0, 1), cB + hstep, voffB); PG8_STAGE(PG8_SA(0, 0), cA, voffA); PG8_STAGE(PG8_SA(0, 1), cA + hstep, voffA);
    if (wr == 1) PG8_BAR;
    PG8_WAIT_V(2); PG8_BAR;
    PG8_STAGE(PG8_SB(1, 0), cB + kstep, voffB); PG8_STAGE(PG8_SA(1, 0), cA + kstep, voffA); PG8_STAGE(PG8_SB(1, 1), cB + hstep + kstep, voffB);
    PG8_WAIT_V(6); PG8_BAR;
    for (;;) {
        const bool has_next = S.next(ui + 1, nxt);
        const char* nA = has_next ? (const char*)g.A + (size_t)nxt.arow * rstep : cA; const char* nB = has_next ? (const char*)g.Bt + (size_t)nxt.brow * rstep : cB;
        for (int t = 0; t < nt; t += 2) {
            const bool last = (t == nt - 2);
            const char* a1 = cA + (size_t)(t + 1) * kstep;
            const char* a2 = last ? nA : cA + (size_t)(t + 2) * kstep; const char* b2 = last ? nB : cB + (size_t)(t + 2) * kstep;
            const char* a3 = a2 + kstep; const char* b3 = b2 + kstep;
            PG8_LDB(B0, 0, 0); PG8_LDB(B1, 0, 1); PG8_SCHED; PG8_LDA(At, 0, 0); PG8_STAGE(PG8_SA(1, 1), a1 + hstep, voffA);
            PG8_WAIT_V(8); PG8_WAIT_L(0); PG8_BAR; PG8_MMA(0, 0, At, B0); PG8_MMA(0, 1, At, B1); PG8_BAR; PG8_SCHED;
            PG8_LDA(At, 0, 1); PG8_STAGE(PG8_SB(0, 0), b2, voffB); PG8_STAGE(PG8_SB(0, 1), b2 + hstep, voffB); PG8_STAGE(PG8_SA(0, 0), a2, voffA);
            PG8_WAIT_V(8); PG8_WAIT_L(0); PG8_BAR; PG8_MMA(1, 0, At, B0); PG8_MMA(1, 1, At, B1); PG8_BAR; PG8_SCHED;
            PG8_LDB(B0, 1, 0); PG8_LDB(B1, 1, 1); PG8_SCHED; PG8_LDA(At, 1, 0); PG8_STAGE(PG8_SA(0, 1), a2 + hstep, voffA);
            PG8_WAIT_V(8); PG8_WAIT_L(0); PG8_BAR; PG8_MMA(0, 0, At, B0); PG8_MMA(0, 1, At, B1); PG8_BAR; PG8_SCHED;
            PG8_LDA(At, 1, 1); PG8_STAGE(PG8_SB(1, 0), b3, voffB); PG8_STAGE(PG8_SB(1, 1), b3 + hstep, voffB); PG8_STAGE(PG8_SA(1, 0), a3, voffA);
            PG8_WAIT_V(8); PG8_WAIT_L(0); PG8_BAR; PG8_MMA(1, 0, At, B0); PG8_MMA(1, 1, At, B1); PG8_BAR; PG8_SCHED;
        }
        if constexpr (ALIGN_EPI) { if (wr == 0) PG8_BAR; }
        { int tz = tid; asm volatile("" : "+v"(tz));
            const int wid_e = __builtin_amdgcn_readfirstlane(tz >> 6), lane_e = tz & 63; E(acc, cur, wid_e >> 2, wid_e & 3, lane_e & 15, lane_e >> 4); }
        if (!has_next) break;
#pragma unroll
        for (int a = 0; a < 2; ++a)
#pragma unroll
            for (int b = 0; b < 2; ++b)
#pragma unroll
                for (int m = 0; m < 4; ++m)
#pragma unroll
                    for (int n = 0; n < 2; ++n) acc[a][b][m][n] = (f32x4){0.f, 0.f, 0.f, 0.f};
        cur = nxt; cA = nA; cB = nB; ++ui;
        if constexpr (ALIGN_EPI) { if (wr == 1) PG8_BAR; }
    }
    PG8_WAIT_V(0);
    if constexpr (!ALIGN_EPI) { if (wr == 0) PG8_BAR; }
    PG8_BAR;
#undef PG8_SA
#undef PG8_SB
#undef PG8_STAGE
#undef PG8_LDA
#undef PG8_LDB
#undef PG8_MMA
#undef PG8_LD2
#undef PG8_LO
#undef PG8_HI
#undef PG8_WAIT_V
#undef PG8_WAIT_L
#undef PG8_BAR
#undef PG8_SCHED
}
}

#define XB_TMO      128
#define XB_XCNT(j)  (256  + 64 * (j))
#define XB_XSUB(j)  (1280 + 64 * (j))
#define XB_XGEN(j)  (2304 + 64 * (j))
#define XB_TOP      3328
#define XB_TOPGEN   3392
#define XCD_BAR_WORDS 3456
#define XB_SPIN_CAP (1u << 18)
__device__ __forceinline__ unsigned xb_ld(unsigned* p)              { return __hip_atomic_load(p, __ATOMIC_RELAXED, __HIP_MEMORY_SCOPE_AGENT); }
__device__ __forceinline__ unsigned xb_add(unsigned* p, unsigned v) { return __hip_atomic_fetch_add(p, v, __ATOMIC_RELAXED, __HIP_MEMORY_SCOPE_AGENT); }
__device__ __forceinline__ unsigned xb_xcc_id() { return (unsigned)__builtin_amdgcn_s_getreg((3 << 11) | 20) & 0xFu; }
#define XB_SPIN(cond, bar) do { unsigned _sp = 0; while (cond) { __builtin_amdgcn_s_sleep(1); \
    if ((++_sp & 255u) == 0u) { if (xb_ld(&(bar)[XB_TMO])) break; if (_sp > XB_SPIN_CAP) { atomicAdd(&(bar)[XB_TMO], 1u); break; } } } } while (0)
struct XcdBarrier { unsigned* bar; unsigned x; volatile LAS unsigned* st; };
__device__ __forceinline__ XcdBarrier xcd_barrier_post(unsigned* bar, volatile LAS unsigned* st) {
    XcdBarrier b; b.bar = bar; b.x = xb_xcc_id(); b.st = st;
    if (threadIdx.x == 0) (void)xb_add(&bar[XB_XCNT(b.x)], 1u);
    return b;
}
__device__ __forceinline__ void xcd_barrier_complete(unsigned* bar, unsigned x, unsigned& nloc, unsigned& nx) {
    const unsigned G = gridDim.x * gridDim.y * gridDim.z;
    unsigned sum, cnt, mine, sp = 0u;
    for (;;) {
        sum = 0u; cnt = 0u; mine = 0u;
#pragma unroll
        for (unsigned j = 0; j < 16; ++j) { const unsigned c = xb_ld(&bar[XB_XCNT(j)]); sum += c; cnt += (c > 0u) ? 1u : 0u; mine = (j == x) ? c : mine; }
        if (sum == G) break;
        __builtin_amdgcn_s_sleep(1);
        if ((++sp & 255u) == 0u) { if (xb_ld(&bar[XB_TMO])) break; if (sp > XB_SPIN_CAP) { atomicAdd(&bar[XB_TMO], 1u); break; } }
    }
    nloc = mine > 0u ? mine : 1u; nx = cnt > 0u ? cnt : 1u;
}
__device__ __forceinline__ void xcd_barrier(const XcdBarrier& b) {
    asm volatile("s_waitcnt vmcnt(0)" ::: "memory");
    __syncthreads();
    if (threadIdx.x == 0) {
        unsigned* bar = b.bar;
        __builtin_amdgcn_s_waitcnt(0);
        unsigned nloc = b.st[0], nx = b.st[1];
        if (nloc == 0u) { xcd_barrier_complete(bar, b.x, nloc, nx); b.st[0] = nloc; b.st[1] = nx; }
        const unsigned old = xb_add(&bar[XB_XSUB(b.x)], 1u);
        const unsigned gen = old / nloc;
        if (old + 1u == (gen + 1u) * nloc) {
            __builtin_amdgcn_fence(__ATOMIC_RELEASE, "agent");
            asm volatile("s_waitcnt vmcnt(0)" ::: "memory");
            const unsigned og = xb_add(&bar[XB_TOP], 1u);
            const unsigned tg = og / nx;
            if (og + 1u == (tg + 1u) * nx) xb_add(&bar[XB_TOPGEN], 1u);
            else XB_SPIN(xb_ld(&bar[XB_TOPGEN]) == tg, bar);
            __builtin_amdgcn_fence(__ATOMIC_ACQUIRE, "agent");
            xb_add(&bar[XB_XGEN(b.x)], 1u);
            asm volatile("s_waitcnt vmcnt(0)" ::: "memory");
        } else {
            XB_SPIN(xb_ld(&bar[XB_XGEN(b.x)]) == gen, bar);
            __builtin_amdgcn_fence(__ATOMIC_ACQUIRE, "agent");
            asm volatile("s_waitcnt vmcnt(0)" ::: "memory");
        }
    }
    __syncthreads();
}

struct Args { const float* in[27]; float* out; unsigned char* ws; int ph_lo, ph_hi; };
struct Frame {
    LAS unsigned char* lds;
    volatile LAS unsigned* MISC;
    gu32* ctl;
    int tid, lane, wave, G, bx;
    GAS unsigned char* ws;
};

struct CvItem { const gf32* W; GAS unsigned char* WT; int ldw, K, k0, s0, n0; bool f8; };
__device__ __forceinline__ void tr_load(f32x4 (&v)[16], const CvItem& c, int lane) {
    const gf32* src = c.W + (size_t)(c.k0 + (lane >> 4)) * c.ldw + c.s0 + 4 * (lane & 15);
#pragma unroll
    for (int i = 0; i < 16; ++i) { v[i] = *(const GAS f32x4*)src; src += 4 * c.ldw; }
}
__device__ __forceinline__ void tr_store(const f32x4 (&v)[16], const CvItem& cv, LAS float* scr, int lane) {
    const int l16 = lane & 15, lq = lane >> 4, c = lane & 7;
    LAS float* p = scr + lq * 65 + 4 * l16;
#pragma unroll
    for (int i = 0; i < 16; ++i) { p[i * 260 + 0] = v[i][0]; p[i * 260 + 1] = v[i][1]; p[i * 260 + 2] = v[i][2]; p[i * 260 + 3] = v[i][3]; }
    LDS_WAIT(); asm volatile("" ::: "memory");
    const LAS float* s = scr + (8 * c) * 65 + (lane >> 3);
    if (cv.f8) {
        GAS unsigned char* dst = cv.WT + (size_t)(cv.n0 + (lane >> 3)) * cv.K + cv.k0 + 8 * c;
#pragma unroll
        for (int j = 0; j < 8; ++j) {
            u32x2 o; o.x = pk4_fp8(s[8 * j + 0 * 65] * W8_SCALE, s[8 * j + 1 * 65] * W8_SCALE, s[8 * j + 2 * 65] * W8_SCALE, s[8 * j + 3 * 65] * W8_SCALE);
            o.y = pk4_fp8(s[8 * j + 4 * 65] * W8_SCALE, s[8 * j + 5 * 65] * W8_SCALE, s[8 * j + 6 * 65] * W8_SCALE, s[8 * j + 7 * 65] * W8_SCALE);
            *(GAS u32x2*)dst = o; dst += (size_t)8 * cv.K; }
    } else {
        GAS unsigned char* dst = cv.WT + ((size_t)(cv.n0 + (lane >> 3)) * cv.K + cv.k0 + 8 * c) * 2;
#pragma unroll
        for (int j = 0; j < 8; ++j) {
            u32x4 o; o.x = pk2(s[8 * j + 0 * 65], s[8 * j + 1 * 65]); o.y = pk2(s[8 * j + 2 * 65], s[8 * j + 3 * 65]); o.z = pk2(s[8 * j + 4 * 65], s[8 * j + 5 * 65]); o.w = pk2(s[8 * j + 6 * 65], s[8 * j + 7 * 65]);
            *(GAS u32x4*)dst = o; dst += (size_t)16 * cv.K; }
    }
    LDS_WAIT(); asm volatile("" ::: "memory");
}
constexpr int I_IN = 32 * 104, I_OUT = 32 * 32, I_GU = 32 * 176, I_DN = 88 * 32;
constexpr int I_EXP = I_GU + I_DN, NITEMS = 2 * I_IN + 2 * I_OUT + (1 + NE) * I_EXP;
struct CvSrc { const gf32 *w_in, *w_out, *fg, *fu, *fd, *mg, *mu, *md; };
__device__ __forceinline__ CvItem cv_decode(Frame& F, int pair, int half, const CvSrc& a) {
    int r = pair; CvItem c; c.f8 = false;
    if (r < 2 * I_IN) { const int l = r / I_IN; r -= l * I_IN; const int q = r >> 1, kb = 2 * (q / 104), nb = q % 104; c.n0 = 64 * nb; c.k0 = 64 * kb;
        c.W = a.w_in + (size_t)l * D * DIN; c.ldw = DIN; c.s0 = c.n0 < 4608 ? c.n0 : c.n0 + 12; c.WT = F.ws + WS_WIN + (size_t)l * SZ_WIN; c.K = D; }
    else if (r < 2 * I_IN + 2 * I_OUT) { r -= 2 * I_IN; const int l = r / I_OUT; r -= l * I_OUT; const int q = r >> 1, kb = 2 * (q / 32), nb = q % 32; c.n0 = 64 * nb; c.k0 = 64 * kb;
        c.W = a.w_out + (size_t)l * D * D; c.ldw = D; c.s0 = c.n0; c.WT = F.ws + WS_WOUT + (size_t)l * SZ_WOUT; c.K = D; }
    else { r -= 2 * I_IN + 2 * I_OUT;
        const int grp = r / I_EXP; r -= grp * I_EXP; const int e = grp - 1; c.f8 = (grp != 0) || (DENSE_GU_F8 && r < I_GU);
        if (r < I_GU) { const int q = r >> 1, kb = 2 * (q / 176), nb = q % 176; c.n0 = 64 * nb; c.k0 = 64 * kb; const int pn = c.n0 >> 8, r0 = c.n0 & 255;
            const gf32* Wg = grp == 0 ? a.fg : a.mg + (size_t)e * D * DFF; const gf32* Wu = grp == 0 ? a.fu : a.mu + (size_t)e * D * DFF;
            c.W = r0 < 128 ? Wg : Wu; c.ldw = DFF; c.s0 = 128 * pn + (r0 & 127); c.WT = grp == 0 ? (F.ws + WS_WGU) : (F.ws + WS_MGU) + (size_t)e * 2 * DFF * D; c.K = D; }
        else { r -= I_GU; const int q = r >> 1, kb = 2 * (q / 32), nb = q % 32; c.n0 = 64 * nb; c.k0 = 64 * kb;
            c.W = grp == 0 ? a.fd : a.md + (size_t)e * DFF * D; c.ldw = D; c.s0 = c.n0; c.WT = grp == 0 ? (F.ws + WS_WDN) : (F.ws + WS_MDN) + (size_t)e * D * DFF; c.K = DFF; } }
    c.k0 += 64 * half;
    return c;
}
template <class Map> __device__ __forceinline__ void cv_run(Frame& F, int first, int stride, int n, Map map, const CvSrc& a, LAS float* scr) {
    if (n <= 0) return;
    f32x4 va[16], vb[16];
    CvItem ca = cv_decode(F, map(first), 0, a), cb; tr_load(va, ca, F.lane);
#pragma unroll 1
    for (int j = 0; j < n; ++j) {
        cb = cv_decode(F, map(first + j * stride), 1, a); tr_load(vb, cb, F.lane);
        tr_store(va, ca, scr, F.lane);
        if (j + 1 < n) { ca = cv_decode(F, map(first + (j + 1) * stride), 0, a); tr_load(va, ca, F.lane); }
        tr_store(vb, cb, scr, F.lane);
    }
}
constexpr int N_IMM = I_IN + I_OUT + I_EXP, N_DEF = NITEMS - N_IMM, N_DEF_UNITS = N_DEF / 64;
static_assert(N_DEF % 64 == 0, "deferred conversion units");
__device__ __forceinline__ int imm_item(int i) { return i < I_IN ? i : (i < I_IN + I_OUT ? 2 * I_IN + (i - I_IN) : 2 * I_IN + 2 * I_OUT + (i - I_IN - I_OUT)); }
__device__ __forceinline__ int def_item(int d) { return d < I_IN ? I_IN + d : (d < I_IN + I_OUT ? 2 * I_IN + I_OUT + (d - I_IN) : 2 * I_IN + 2 * I_OUT + I_EXP + (d - I_IN - I_OUT)); }
__device__ __forceinline__ void p0_prologue(Frame& F, const Args& a) {
    LAS float* scr = (LAS float*)(F.lds) + F.wave * (64 * 65);
    const int gw = F.bx * NWAVES + F.wave, NGW = F.G * NWAVES;
    gbf* Win = (gbf*)(F.ws + WS_WIN);
    { const CvSrc src{(const gf32*)a.in[3], (const gf32*)a.in[18], (const gf32*)a.in[20], (const gf32*)a.in[21], (const gf32*)a.in[22], (const gf32*)a.in[24], (const gf32*)a.in[25], (const gf32*)a.in[26]};
        const int npairs = N_IMM / 2, mine = gw < npairs ? (npairs - gw + NGW - 1) / NGW : 0;
        cv_run(F, 2 * gw, 2 * NGW, mine, [](int i) { return imm_item(i); }, src, scr); }
    for (int i = F.bx * NTHR + F.tid; i < 2 * 256 * (D / 8); i += F.G * NTHR) {
        const int l = i / (256 * (D / 8)), rr = i % (256 * (D / 8)), n = rr / (D / 8), k8 = rr % (D / 8);
        const int src = n < 12 ? 4608 + n : (n < 24 ? 6668 + (n - 12) : -1);
        u32x4 o = {0u, 0u, 0u, 0u};
        if (src >= 0) { const gf32* w = (const gf32*)a.in[3] + (size_t)l * D * DIN + (size_t)(8 * k8) * DIN + src;
            o.x = pk2(w[0], w[DIN]); o.y = pk2(w[2 * DIN], w[3 * DIN]); o.z = pk2(w[4 * DIN], w[5 * DIN]); o.w = pk2(w[6 * DIN], w[7 * DIN]); }
        *(GAS u32x4*)(Win + (size_t)l * NPJ * D + (size_t)(PC_SMALL + n) * D + 8 * k8) = o;
    }
}

template <bool ROUTER, bool F8OUT>
__device__ __forceinline__ void norm_phase(Frame& F, const gf32* x, const gf32* gain, gbf* Hout, const gf32* router) {
    const int tpw = (M + F.G - 1) / F.G, m0 = F.bx * tpw, m1 = (m0 + tpw < M) ? m0 + tpw : M;
    LAS float* RT = (LAS float*)F.lds;
    LAS int* hist = (LAS int*)(F.lds + 65536);
    if (ROUTER) {
        for (int i = F.tid; i < D * NE; i += NTHR) RT[(i & 7) * D + (i >> 3)] = router[i];
        if (F.tid < 8) hist[F.tid] = 0;
        __syncthreads();
    }
    gi32* toke = (gi32*)(F.ws + WS_ROUTE + RT_TOKE); gf32* tokw = (gf32*)(F.ws + WS_ROUTE + RT_TOKW);
    for (int m = m0 + F.wave; m < m1; m += NWAVES) {
        const GAS f32x4* xr = (const GAS f32x4*)(x + (size_t)m * D) + F.lane;
        f32x4 v[8]; float s = 0.f;
#pragma unroll
        for (int j = 0; j < 8; ++j) { v[j] = xr[64 * j]; s += (v[j].x * v[j].x + v[j].y * v[j].y) + (v[j].z * v[j].z + v[j].w * v[j].w); }
        const float rstd = 1.0f / sqrtf(wave_sum(s, F.lane) * (1.0f / D) + NORM_EPS);
        GAS u32x2* o8 = (GAS u32x2*)(Hout + (size_t)m * D) + F.lane; GAS unsigned* o4 = (GAS unsigned*)((GAS unsigned char*)Hout + (size_t)m * D) + F.lane;
#pragma unroll
        for (int j = 0; j < 8; ++j) { const f32x4 g = ((const GAS f32x4*)gain)[F.lane + 64 * j]; v[j] = v[j] * rstd * g;
            if (F8OUT) o4[64 * j] = pk4_fp8_sat(v[j].x, v[j].y, v[j].z, v[j].w);
            else { u32x2 w; w.x = pk2(v[j].x, v[j].y); w.y = pk2(v[j].z, v[j].w); o8[64 * j] = w; } }
        if (ROUTER) {
            float lg[8];
#pragma unroll
            for (int e = 0; e < 8; ++e) { float acc = 0.f;
#pragma unroll
                for (int j = 0; j < 8; ++j) { const f32x4 r = *(const LAS f32x4*)(RT + e * D + 4 * F.lane + 256 * j); acc += (v[j].x * r.x + v[j].y * r.y) + (v[j].z * r.z + v[j].w * r.w); }
                lg[e] = wave_sum(acc, F.lane); }
            int e1 = 0; float v1 = lg[0];
#pragma unroll
            for (int e = 1; e < 8; ++e) if (lg[e] > v1) { v1 = lg[e]; e1 = e; }
            int e2 = -1; float v2 = -3.0e38f;
#pragma unroll
            for (int e = 0; e < 8; ++e) if (e != e1 && lg[e] > v2) { v2 = lg[e]; e2 = e; }
            const float t = __expf(v2 - v1), w1 = 1.0f / (1.0f + t), w2 = t * w1;
            if (F.lane == 0) { toke[m] = e1 | (e2 << 8); tokw[2 * m] = w1; tokw[2 * m + 1] = w2; __hip_atomic_fetch_add(&hist[e1], 1, __ATOMIC_RELAXED, __HIP_MEMORY_SCOPE_WORKGROUP); __hip_atomic_fetch_add(&hist[e2], 1, __ATOMIC_RELAXED, __HIP_MEMORY_SCOPE_WORKGROUP); }
        }
    }
    if (ROUTER) {
        __syncthreads();
        if (F.tid < 8) ((gi32*)(F.ws + WS_ROUTE + RT_WGCNT))[F.bx * 8 + F.tid] = hist[F.tid];
    }
}

__device__ __forceinline__ void route_phase(Frame& F) {
    const int tpw = (M + F.G - 1) / F.G, m0 = F.bx * tpw, m1 = (m0 + tpw < M) ? m0 + tpw : M, nt = (m1 > m0) ? (m1 - m0) : 0;
    LAS int* tot = (LAS int*)F.lds;
    LAS int* pre = tot + 8;
    LAS int* base = tot + 16;
    LAS int* offs = tot + 24;
    LAS int* aexp = tot + 64;
    LAS int* apos = aexp + 2 * 128;
    const gi32* wgcnt = (const gi32*)(F.ws + WS_ROUTE + RT_WGCNT);
    const gi32* toke = (const gi32*)(F.ws + WS_ROUTE + RT_TOKE); const gf32* tokw = (const gf32*)(F.ws + WS_ROUTE + RT_TOKW);
    gi32* stok = (gi32*)(F.ws + WS_ROUTE + RT_STOK); gi32* tpos = (gi32*)(F.ws + WS_ROUTE + RT_TPOS); gf32* sw = (gf32*)(F.ws + WS_ROUTE + RT_SW); gi32* tab = (gi32*)(F.ws + WS_ROUTE + RT_TAB);
    if (F.tid < 16) tot[F.tid] = 0;
    __syncthreads();
    for (int i = F.tid; i < F.G * 8; i += NTHR) { const int v = wgcnt[i]; __hip_atomic_fetch_add(&tot[i & 7], v, __ATOMIC_RELAXED, __HIP_MEMORY_SCOPE_WORKGROUP); if ((i >> 3) < F.bx) __hip_atomic_fetch_add(&pre[i & 7], v, __ATOMIC_RELAXED, __HIP_MEMORY_SCOPE_WORKGROUP); }
    __syncthreads();
    if (F.tid == 0) { int o = 0; for (int e = 0; e < 8; ++e) { offs[e] = o; base[e] = o + pre[e]; o += tot[e]; } offs[8] = o; }
    for (int a = F.tid; a < 2 * nt; a += NTHR) { const int te = toke[m0 + (a >> 1)]; aexp[a] = (a & 1) ? (te >> 8) : (te & 0xff); }
    __syncthreads();
    for (int a = F.tid; a < 2 * nt; a += NTHR) { const int ea = aexp[a]; int rank = 0; for (int b = 0; b < a; ++b) rank += (aexp[b] == ea) ? 1 : 0;
        const int p = base[ea] + rank; apos[a] = p; stok[p] = m0 + (a >> 1); sw[p] = tokw[2 * (m0 + (a >> 1)) + (a & 1)]; tpos[2 * m0 + a] = p; }
    __syncthreads();
    const gbf* H = (const gbf*)(F.ws + WS_H); gbf* HG = (gbf*)(F.ws + WS_HG);
#pragma unroll 1
    for (int i0 = F.tid; i0 < 2 * nt * 128; i0 += 8 * NTHR) { u32x4 r[8];
#pragma unroll
        for (int u = 0; u < 8; ++u) { const int i = i0 + u * NTHR; const int ii = i < 2 * nt * 128 ? i : 0; r[u] = *(const GAS u32x4*)((const GAS unsigned char*)H + (size_t)(m0 + (ii >> 8)) * D + 16 * (ii & 127)); }
#pragma unroll
        for (int u = 0; u < 8; ++u) { const int i = i0 + u * NTHR; if (i < 2 * nt * 128) *(GAS u32x4*)((GAS unsigned char*)HG + (size_t)apos[i >> 7] * D + 16 * (i & 127)) = r[u]; } }
    if (F.bx == 0 && F.tid == 0) { int T = 0;
        for (int e = 0; e < 8; ++e) { const int cnt = tot[e]; for (int r = 0; r < cnt; r += 256) { tab[4 + 4 * T] = e; tab[5 + 4 * T] = offs[e] + r; tab[6 + 4 * T] = (cnt - r < 256) ? cnt - r : 256; tab[7 + 4 * T] = 0; ++T; } }
        tab[0] = T; }
    __syncthreads();
}

constexpr size_t SCR_QN = 0, SCR_KN = 16 * MiB, SCR_VT = 32 * MiB;
constexpr size_t SCR_GW = 48 * MiB, SCR_GQD = 72 * MiB, SCR_GKDT = 96 * MiB, SCR_GUT = 120 * MiB, SCR_GQK = 144 * MiB, SCR_GDEC = 156 * MiB;
constexpr size_t SCR_ST = 157 * MiB, SCR_PREV = 205 * MiB, SCR_CDEC = 229 * MiB, SCR_END = 230 * MiB;
static_assert(WS_SCR + SCR_END <= WS_BIG + (size_t)600 * MiB, "scratch");
constexpr float LOG2E = 1.4426950408889634f;
constexpr size_t WS_NEED = (WS_SCR + SCR_END > WS_END_MOE) ? WS_SCR + SCR_END : WS_END_MOE;

__device__ __forceinline__ bf16x8 ld_frag16(const LAS unsigned char* p) { return *(const LAS bf16x8*)p; }
__device__ __forceinline__ bf16x8 ld_frag8x2(const LAS unsigned char* p0, const LAS unsigned char* p1) {
    const s16x4 a = *(const LAS s16x4*)p0, b = *(const LAS s16x4*)p1; return (bf16x8){a[0], a[1], a[2], a[3], b[0], b[1], b[2], b[3]}; }
__device__ __forceinline__ bf16x8 pack_frag(const f32x4 a, const f32x4 b) {
    u32x4 w; w.x = pk2(a[0], a[1]); w.y = pk2(a[2], a[3]); w.z = pk2(b[0], b[1]); w.w = pk2(b[2], b[3]); return __builtin_bit_cast(bf16x8, w); }
#define MFMA16(a, b, c) __builtin_amdgcn_mfma_f32_16x16x32_bf16((a), (b), (c), 0, 0, 0)

__device__ __forceinline__ void attn_prep_unit(Frame& F, int u, const gf32* qgain, const gf32* kgain) {
    const gbf* PROJ = (const gbf*)(F.ws + WS_PROJ);
    gbf* QN = (gbf*)(F.ws + WS_SCR + SCR_QN); gbf* KN = (gbf*)(F.ws + WS_SCR + SCR_KN); gbf* VT = (gbf*)(F.ws + WS_SCR + SCR_VT);
    const int m0 = 64 * u, b = m0 >> 12, t0 = m0 & 4095;
    for (int task = F.tid; task < 1024; task += NTHR) {
        const int tok = task >> 4, grp = task & 15, isk = grp >> 3, g8 = grp & 7;
        const gbf* src = PROJ + (size_t)(m0 + tok) * NPJ + (isk ? PC_AK : PC_AQ) + g8 * 64;
        u32x4 w[8]; float ss = 0.f;
#pragma unroll
        for (int i = 0; i < 8; ++i) { w[i] = *(const GAS u32x4*)(src + 8 * i);
#pragma unroll
            for (int k = 0; k < 4; ++k) { const float a = bflo(w[i][k]), c = bfhi(w[i][k]); ss += a * a + c * c; } }
        const float r = (1.0f / sqrtf(ss * (1.0f / 64.f) + NORM_EPS)) * (isk ? 1.0f : 0.125f * LOG2E);
        const gf32* gn = isk ? kgain : qgain; gbf* dst = (isk ? KN : QN) + (size_t)(m0 + tok) * 512 + g8 * 64;
#pragma unroll
        for (int i = 0; i < 8; ++i) { const f32x4 g0 = *(const GAS f32x4*)(gn + 8 * i), g1 = *(const GAS f32x4*)(gn + 8 * i + 4); u32x4 o;
            o.x = pk2(bflo(w[i].x) * r * g0.x, bfhi(w[i].x) * r * g0.y); o.y = pk2(bflo(w[i].y) * r * g0.z, bfhi(w[i].y) * r * g0.w);
            o.z = pk2(bflo(w[i].z) * r * g1.x, bfhi(w[i].z) * r * g1.y); o.w = pk2(bflo(w[i].w) * r * g1.z, bfhi(w[i].w) * r * g1.w);
            *(GAS u32x4*)(dst + 8 * i) = o; }
    }
    LAS unsigned char* Vs = F.lds;
    for (int idx = F.tid; idx < 4096; idx += NTHR) { const int tok = idx >> 6, c16 = idx & 63;
        *(LAS u32x4*)(Vs + tok * 1040 + c16 * 16) = *(const GAS u32x4*)(PROJ + (size_t)(m0 + tok) * NPJ + PC_AV + 8 * c16); }
    __syncthreads();
    for (int idx = F.tid; idx < 4096; idx += NTHR) { const int row = idx >> 3, ch = idx & 7;
        unsigned short e[8];
#pragma unroll
        for (int j = 0; j < 8; ++j) e[j] = *(const LAS unsigned short*)(Vs + (8 * ch + j) * 1040 + 2 * row);
        u32x4 o; o.x = e[0] | ((unsigned)e[1] << 16); o.y = e[2] | ((unsigned)e[3] << 16); o.z = e[4] | ((unsigned)e[5] << 16); o.w = e[6] | ((unsigned)e[7] << 16);
        *(GAS u32x4*)(VT + ((size_t)(b * 4 + (row >> 7)) * 128 + (row & 127)) * SEQ + t0 + 8 * ch) = o; }
    __syncthreads();
}

template <bool ROWMAJOR, class Sc, class St>
__device__ __forceinline__ void conv8x16(const gbf* src, bool has_halo, const gf32* w, int NC, const gf32* bias, Sc scale, St store) {
    u32x4 x[19];
#pragma unroll
    for (int i = 0; i < 3; ++i) x[i] = has_halo ? *(const GAS u32x4*)(src + (i - 3) * NPJ) : (u32x4){0u, 0u, 0u, 0u};
#pragma unroll
    for (int i = 3; i < 19; ++i) x[i] = *(const GAS u32x4*)(src + (i - 3) * NPJ);
    float wt[4][8], bs[8];
#pragma unroll
    for (int j = 0; j < 4; ++j) { const f32x4 a = *(const GAS f32x4*)(w + j * NC), c = *(const GAS f32x4*)(w + j * NC + 4);
        wt[j][0] = a.x; wt[j][1] = a.y; wt[j][2] = a.z; wt[j][3] = a.w; wt[j][4] = c.x; wt[j][5] = c.y; wt[j][6] = c.z; wt[j][7] = c.w; }
    if (bias) { const f32x4 a = *(const GAS f32x4*)bias, c = *(const GAS f32x4*)(bias + 4); bs[0] = a.x; bs[1] = a.y; bs[2] = a.z; bs[3] = a.w; bs[4] = c.x; bs[5] = c.y; bs[6] = c.z; bs[7] = c.w; }
    else {
#pragma unroll
        for (int k = 0; k < 8; ++k) bs[k] = 0.f; }
#define CX(i, k) (((k) & 1) ? bfhi(x[i][(k) >> 1]) : bflo(x[i][(k) >> 1]))
    if (ROWMAJOR) {
#pragma unroll
        for (int i = 0; i < 16; ++i) { const float sc = scale(i); float v[8];
#pragma unroll
            for (int k = 0; k < 8; ++k) v[k] = silu_f(wt[0][k] * CX(i, k) + wt[1][k] * CX(i + 1, k) + wt[2][k] * CX(i + 2, k) + wt[3][k] * CX(i + 3, k) + bs[k]) * sc;
            store(i, (u32x4){pk2(v[0], v[1]), pk2(v[2], v[3]), pk2(v[4], v[5]), pk2(v[6], v[7])}, (u32x4){0u, 0u, 0u, 0u}); }
    } else {
#pragma unroll
        for (int k = 0; k < 8; ++k) { float v[16];
#pragma unroll
            for (int i = 0; i < 16; ++i) v[i] = silu_f(wt[0][k] * CX(i, k) + wt[1][k] * CX(i + 1, k) + wt[2][k] * CX(i + 2, k) + wt[3][k] * CX(i + 3, k) + bs[k]) * scale(i);
            store(k, (u32x4){pk2(v[0], v[1]), pk2(v[2], v[3]), pk2(v[4], v[5]), pk2(v[6], v[7])}, (u32x4){pk2(v[8], v[9]), pk2(v[10], v[11]), pk2(v[12], v[13]), pk2(v[14], v[15])}); }
    }
#undef CX
}

__device__ __forceinline__ void gdn_prep_unit(Frame& F, int up, const gf32* convw, const gf32* A_log, const gf32* dt_bias) {
    const gbf* PROJ = (const gbf*)(F.ws + WS_PROJ); const gf32* SMALL = (const gf32*)(F.ws + WS_SMALL);
    const int bh = up >> 5, np = up & 31, b = bh / 6, h = bh % 6, t0 = 128 * np;
    LAS unsigned char* L = F.lds;
    LAS unsigned char* Qb = L; LAS unsigned char* Kb = L + 34816; LAS unsigned char* Vb = L + 69632;
    LAS float* Am = (LAS float*)(L + 104448);
    LAS float* gcs = (LAS float*)(L + 137216); LAS float* betas = gcs + 128; LAS float* rqs = gcs + 256; LAS float* rks = gcs + 384;
    if (F.tid < 384) { const int ch = F.tid / 192, rem = F.tid % 192, oct = rem >> 2, seg = rem & 3, part = oct >> 4, d0 = (oct & 15) * 8;
        const int cidx = part * 768 + h * 128 + d0, tr = t0 + 64 * ch + 16 * seg;
        LAS unsigned char* dst = (part == 0 ? Qb : (part == 1 ? Kb : Vb)) + ch * 17408 + (16 * seg) * 272 + d0 * 2;
        conv8x16<true>(PROJ + (size_t)(b * SEQ + tr) * NPJ + PC_GQKV + cidx, tr > 0, convw + cidx, 2304, (const gf32*)nullptr, [](int) { return 1.0f; },
                       [&](int i, u32x4 a, u32x4) { *(LAS u32x4*)(dst + i * 272) = a; });
    }
    if ((F.tid & 255) < 64) { const int ch = F.tid >> 8, c = F.tid & 63; const size_t m = (size_t)(b * SEQ + t0 + 64 * ch + c);
        const float beta = sigmoid_f(SMALL[m * 32 + h]);
        const float g = -__expf(A_log[h]) * softplus_f(SMALL[m * 32 + 6 + h] + dt_bias[h]);
        float s = g;
#pragma unroll
        for (int o = 1; o < 64; o <<= 1) { const float t = __builtin_bit_cast(float, __builtin_amdgcn_ds_bpermute(((F.lane - o) & 63) << 2, __builtin_bit_cast(int, s))); if (c >= o) s += t; }
        gcs[ch * 64 + c] = s; betas[ch * 64 + c] = beta; }
    __syncthreads();
    { const int ch = F.tid >> 8, isk = (F.tid >> 7) & 1, c = (F.tid >> 1) & 63, part = F.tid & 1;
        const LAS unsigned char* row = (isk ? Kb : Qb) + ch * 17408 + c * 272 + part * 128; float ss = 0.f;
#pragma unroll
        for (int i = 0; i < 8; ++i) { const u32x4 w = *(const LAS u32x4*)(row + 16 * i);
#pragma unroll
            for (int k = 0; k < 4; ++k) { const float a = bflo(w[k]), e = bfhi(w[k]); ss += a * a + e * e; } }
        ss += shfl_xor_l(ss, 1, F.lane);
        if (part == 0) (isk ? rks : rqs)[ch * 64 + c] = 1.0f / sqrtf(ss + NORM_EPS); }
    __syncthreads();
    { const int ch = F.wave >> 2, ct = F.wave & 3, fr = F.lane & 15, fq = F.lane >> 4;
        const size_t cu = (size_t)bh * 64 + 2 * np + ch;
        gbf* QKc = (gbf*)(F.ws + WS_SCR + SCR_GQK) + cu * 4096;
        const LAS unsigned char* Kc = Kb + ch * 17408; const LAS unsigned char* Qc = Qb + ch * 17408;
        bf16x8 ka[4], qa[4];
#pragma unroll
        for (int kb = 0; kb < 4; ++kb) { ka[kb] = ld_frag16(Kc + (16 * ct + fr) * 272 + (32 * kb + 8 * fq) * 2); qa[kb] = ld_frag16(Qc + (16 * ct + fr) * 272 + (32 * kb + 8 * fq) * 2); }
#pragma unroll
        for (int st = 0; st < 4; ++st) {
            f32x4 akk = {0.f, 0.f, 0.f, 0.f}, aqk = {0.f, 0.f, 0.f, 0.f};
            if (st <= ct) {
#pragma unroll
                for (int kb = 0; kb < 4; ++kb) { const bf16x8 kbf = ld_frag16(Kc + (16 * st + fr) * 272 + (32 * kb + 8 * fq) * 2); akk = MFMA16(ka[kb], kbf, akk); aqk = MFMA16(qa[kb], kbf, aqk); }
            }
            const int s = 16 * st + fr; const float gs = gcs[ch * 64 + s], rks_s = rks[ch * 64 + s];
#pragma unroll
            for (int j = 0; j < 4; ++j) { const int c = 16 * ct + 4 * fq + j; const float gcv = gcs[ch * 64 + c]; const float dec = __expf(gcv - gs);
                const float av = (c > s) ? betas[ch * 64 + c] * rks[ch * 64 + c] * rks_s * akk[j] * dec : 0.f;
                const float qv = (c >= s) ? rqs[ch * 64 + c] * rks_s * 0.08838834764831845f * aqk[j] * dec : 0.f;
                Am[ch * 4096 + c * 64 + s] = av; QKc[c * 64 + s] = f2bf(qv); }
        }
    }
    __syncthreads();
    { const int ch = F.tid >> 8, col = F.tid & 255; const size_t cu = (size_t)bh * 64 + 2 * np + ch;
        float x[64];
        if (col < 128) {
#pragma unroll
            for (int c = 0; c < 64; ++c) x[c] = bf2f(*(const LAS unsigned short*)(Vb + ch * 17408 + c * 272 + 2 * col)) * betas[ch * 64 + c];
        } else {
#pragma unroll
            for (int c = 0; c < 64; ++c) x[c] = bf2f(*(const LAS unsigned short*)(Kb + ch * 17408 + c * 272 + 2 * (col - 128))) * rks[ch * 64 + c] * betas[ch * 64 + c] * __expf(gcs[ch * 64 + c]);
        }
        const LAS f32x4* A4 = (const LAS f32x4*)(Am + ch * 4096);
#pragma unroll
        for (int c = 1; c < 64; ++c) { float a0 = 0.f, a1 = 0.f, a2 = 0.f, a3 = 0.f;
#pragma unroll
            for (int s4 = 0; s4 < (c + 3) / 4; ++s4) { const f32x4 a = A4[c * 16 + s4];
                a0 += a.x * x[4 * s4]; if (4 * s4 + 1 < c) a1 += a.y * x[4 * s4 + 1]; if (4 * s4 + 2 < c) a2 += a.z * x[4 * s4 + 2]; if (4 * s4 + 3 < c) a3 += a.w * x[4 * s4 + 3]; }
            x[c] -= (a0 + a1) + (a2 + a3); }
        if (col < 128) { gbf* UT = (gbf*)(F.ws + WS_SCR + SCR_GUT) + cu * 8192 + col * 64;
#pragma unroll
            for (int i = 0; i < 8; ++i) { u32x4 o; o.x = pk2(x[8 * i], x[8 * i + 1]); o.y = pk2(x[8 * i + 2], x[8 * i + 3]); o.z = pk2(x[8 * i + 4], x[8 * i + 5]); o.w = pk2(x[8 * i + 6], x[8 * i + 7]); *(GAS u32x4*)(UT + 8 * i) = o; }
        } else { gbf* Wc = (gbf*)(F.ws + WS_SCR + SCR_GW) + cu * 8192 + (col - 128);
#pragma unroll
            for (int c = 0; c < 64; ++c) Wc[c * 128] = f2bf(x[c]); }
    }
    for (int task = F.tid; task < 2048; task += NTHR) { const int ch = task >> 10, c = (task >> 4) & 63, p = task & 15; const size_t cu = (size_t)bh * 64 + 2 * np + ch;
        const u32x4 w = *(const LAS u32x4*)(Qb + ch * 17408 + c * 272 + 16 * p); const float sc = rqs[ch * 64 + c] * 0.08838834764831845f * __expf(gcs[ch * 64 + c]);
        u32x4 o; o.x = pk2(bflo(w.x) * sc, bfhi(w.x) * sc); o.y = pk2(bflo(w.y) * sc, bfhi(w.y) * sc); o.z = pk2(bflo(w.z) * sc, bfhi(w.z) * sc); o.w = pk2(bflo(w.w) * sc, bfhi(w.w) * sc);
        *(GAS u32x4*)((gbf*)(F.ws + WS_SCR + SCR_GQD) + cu * 8192 + c * 128 + 8 * p) = o; }
    for (int task = F.tid; task < 2048; task += NTHR) { const int ch = task >> 10, d = (task >> 3) & 127, o8 = task & 7; const size_t cu = (size_t)bh * 64 + 2 * np + ch;
        const float gl = gcs[ch * 64 + 63]; float v[8];
#pragma unroll
        for (int j = 0; j < 8; ++j) { const int c = 8 * o8 + j; v[j] = bf2f(*(const LAS unsigned short*)(Kb + ch * 17408 + c * 272 + 2 * d)) * rks[ch * 64 + c] * __expf(gl - gcs[ch * 64 + c]); }
        u32x4 o; o.x = pk2(v[0], v[1]); o.y = pk2(v[2], v[3]); o.z = pk2(v[4], v[5]); o.w = pk2(v[6], v[7]);
        *(GAS u32x4*)((gbf*)(F.ws + WS_SCR + SCR_GKDT) + cu * 8192 + d * 64 + 8 * o8) = o; }
    if (F.tid < 2) ((gf32*)(F.ws + WS_SCR + SCR_GDEC))[(size_t)bh * 64 + 2 * np + F.tid] = __expf(gcs[F.tid * 64 + 63]);
    __syncthreads();
}

__device__ __forceinline__ void ssd_dt_acum(Frame& F, int b, int c, int g, const gf32* A_log, const gf32* dt_bias, LAS float* dtl, LAS float* Acl, bool write_cdec) {
    if (F.wave < 6) { const int r = F.wave, hh = 6 * g + r; const size_t m = (size_t)(b * SEQ + 128 * c + 2 * F.lane);
        const gf32* SMALL = (const gf32*)(F.ws + WS_SMALL);
        const float bias = dt_bias[hh], a = -__expf(A_log[hh]);
        const float dt0 = softplus_f(SMALL[m * 32 + 12 + hh] + bias), dt1 = softplus_f(SMALL[(m + 1) * 32 + 12 + hh] + bias);
        const float d0 = a * dt0, d1 = a * dt1; float s = d0 + d1;
#pragma unroll
        for (int o = 1; o < 64; o <<= 1) { const float t = __builtin_bit_cast(float, __builtin_amdgcn_ds_bpermute(((F.lane - o) & 63) << 2, __builtin_bit_cast(int, s))); if (F.lane >= o) s += t; }
        dtl[r * 128 + 2 * F.lane] = dt0; dtl[r * 128 + 2 * F.lane + 1] = dt1; Acl[r * 128 + 2 * F.lane] = s - d1; Acl[r * 128 + 2 * F.lane + 1] = s;
        if (write_cdec && F.lane == 63) ((gf32*)(F.ws + WS_SCR + SCR_CDEC))[(b * 32 + c) * 12 + hh] = __expf(s); }
}
__device__ __forceinline__ void ssd_state_unit(Frame& F, int u, const gf32* convw, const gf32* convb, const gf32* A_log, const gf32* dt_bias) {
    const gbf* PROJ = (const gbf*)(F.ws + WS_PROJ);
    const int b = u >> 6, c = (u >> 1) & 31, g = u & 1;
    LAS float* dtl = (LAS float*)F.lds; LAS float* Acl = dtl + 768;
    LAS unsigned char* BT = F.lds + 6144;
    LAS unsigned char* XsT = F.lds + 40960;
    ssd_dt_acum(F, b, c, g, A_log, dt_bias, dtl, Acl, true);
    __syncthreads();
    gf32* ST = (gf32*)(F.ws + WS_SCR + SCR_ST);
    const int fr = F.lane & 15, fq = F.lane >> 4;
#pragma unroll 1
    for (int half = 0; half < 2; ++half) {
        { const int noct = half == 0 ? 40 : 24;
            if (F.tid < noct * 8) { const int oct = F.tid >> 3, seg = F.tid & 7; const int xo = half == 0 ? oct - 16 : oct;
                const int xc = xo < 0 ? 768 + g * 128 + 8 * oct : (6 * g + 3 * half) * 64 + 8 * xo;
                const int tr = 128 * c + 16 * seg;
                if (xo < 0) { LAS unsigned char* d = BT + (8 * oct) * 272 + (16 * seg) * 2;
                    conv8x16<false>(PROJ + (size_t)(b * SEQ + tr) * NPJ + PC_SXBC + xc, tr > 0, convw + xc, SXBC, convb + xc, [](int) { return 1.0f; },
                                    [&](int k, u32x4 lo, u32x4 hi) { *(LAS u32x4*)(d + k * 272) = lo; *(LAS u32x4*)(d + k * 272 + 16) = hi; });
                } else { const int rr = xo >> 3, r = 3 * half + rr; const float al = Acl[r * 128 + 127]; LAS unsigned char* d = XsT + (8 * xo) * 272 + (16 * seg) * 2;
                    conv8x16<false>(PROJ + (size_t)(b * SEQ + tr) * NPJ + PC_SXBC + xc, tr > 0, convw + xc, SXBC, convb + xc, [&](int i) { return dtl[r * 128 + 16 * seg + i] * __expf(al - Acl[r * 128 + 16 * seg + i]); },
                                    [&](int k, u32x4 lo, u32x4 hi) { *(LAS u32x4*)(d + k * 272) = lo; *(LAS u32x4*)(d + k * 272 + 16) = hi; });
                } } }
        __syncthreads();
        bf16x8 bfm[4];
#pragma unroll
        for (int ks = 0; ks < 4; ++ks) bfm[ks] = ld_frag16(BT + (16 * F.wave + fr) * 272 + (32 * ks + 8 * fq) * 2);
#pragma unroll
        for (int rr = 0; rr < 3; ++rr) { const int hh = 6 * g + 3 * half + rr; gf32* dstp = ST + ((size_t)((b * 32 + c) * 12 + hh)) * 8192;
#pragma unroll
            for (int ph2 = 0; ph2 < 2; ++ph2) { bf16x8 xf[2][4];
#pragma unroll
                for (int p2 = 0; p2 < 2; ++p2)
#pragma unroll
                    for (int ks = 0; ks < 4; ++ks) xf[p2][ks] = ld_frag16(XsT + ((rr * 64 + 16 * (2 * ph2 + p2) + fr) * 272) + (32 * ks + 8 * fq) * 2);
#pragma unroll
                for (int p2 = 0; p2 < 2; ++p2) { const int pt = 2 * ph2 + p2; f32x4 acc = {0.f, 0.f, 0.f, 0.f};
#pragma unroll
                    for (int ks = 0; ks < 4; ++ks) acc = MFMA16(xf[p2][ks], bfm[ks], acc);
#pragma unroll
                    for (int j = 0; j < 4; ++j) dstp[(16 * pt + 4 * fq + j) * 128 + 16 * F.wave + fr] = acc[j]; } } }
        __syncthreads();
    }
}

__device__ __forceinline__ void ssd_scan_phase(Frame& F) {
    const gf32* ST = (const gf32*)(F.ws + WS_SCR + SCR_ST); const gf32* CDEC = (const gf32*)(F.ws + WS_SCR + SCR_CDEC); gbf* PREV = (gbf*)(F.ws + WS_SCR + SCR_PREV);
    for (int i = F.bx * NTHR + F.tid; i < BATCH * SH * 8192 / 2; i += F.G * NTHR) {
        const int e2 = i % 4096, bh = i / 4096, b = bh / 12, hh = bh % 12;
        f32x2 run = {0.f, 0.f};
#pragma unroll 8
        for (int c = 0; c < 32; ++c) { const size_t o = ((size_t)((b * 32 + c) * 12 + hh)) * 8192 + 2 * e2;
            *(GAS unsigned*)(PREV + o) = pk2(run.x, run.y);
            const f32x2 st = *(const GAS f32x2*)(ST + o); const float d = CDEC[(b * 32 + c) * 12 + hh]; run = run * d + st; }
    }
}

__device__ __forceinline__ void ssd_out_unit(Frame& F, int u, const gf32* convw, const gf32* convb, const gf32* A_log, const gf32* dt_bias, const gf32* Dskip) {
    const gbf* PROJ = (const gbf*)(F.ws + WS_PROJ); const gbf* PREV = (const gbf*)(F.ws + WS_SCR + SCR_PREV); gbf* MIX = (gbf*)(F.ws + WS_MIX);
    const int b = u >> 6, c = (u >> 1) & 31, g = u & 1;
    LAS float* dtl = (LAS float*)F.lds; LAS float* Acl = dtl + 768;
    LAS unsigned char* Bm = F.lds + 6144;
    LAS unsigned char* Cm = F.lds + 40960;
    LAS unsigned char* XT = F.lds + 75776;
    ssd_dt_acum(F, b, c, g, A_log, dt_bias, dtl, Acl, false);
    __syncthreads();
    const int fr = F.lane & 15, fq = F.lane >> 4, w = F.wave, lrow = 16 * w + fr, dl = lrow - 4 * fq;
    f32x4 cb[8]; bf16x8 cf[4];
    const size_t m = (size_t)(b * SEQ + 128 * c + lrow);
#pragma unroll 1
    for (int half = 0; half < 2; ++half) {
        { const int noct = half == 0 ? 56 : 24;
            if (F.tid < noct * 8) { const int oct = F.tid >> 3, seg = F.tid & 7; const int xo = half == 0 ? oct - 32 : oct;
                const int xc = xo < 0 ? 768 + (oct >> 4) * 256 + g * 128 + 8 * (oct & 15) : (6 * g + 3 * half) * 64 + 8 * xo;
                const int tr = 128 * c + 16 * seg;
                if (xo < 0) { LAS unsigned char* d = ((oct >> 4) ? Cm : Bm) + (16 * seg) * 272 + 16 * (oct & 15);
                    conv8x16<true>(PROJ + (size_t)(b * SEQ + tr) * NPJ + PC_SXBC + xc, tr > 0, convw + xc, SXBC, convb + xc, [](int) { return 1.0f; },
                                   [&](int i, u32x4 a, u32x4) { *(LAS u32x4*)(d + i * 272) = a; });
                } else { LAS unsigned char* d = XT + (8 * xo) * 272 + (16 * seg) * 2;
                    conv8x16<false>(PROJ + (size_t)(b * SEQ + tr) * NPJ + PC_SXBC + xc, tr > 0, convw + xc, SXBC, convb + xc, [](int) { return 1.0f; },
                                    [&](int k, u32x4 lo, u32x4 hi) { *(LAS u32x4*)(d + k * 272) = lo; *(LAS u32x4*)(d + k * 272 + 16) = hi; });
                } } }
        __syncthreads();
        if (half == 0) {
#pragma unroll
            for (int ks = 0; ks < 4; ++ks) cf[ks] = ld_frag16(Cm + lrow * 272 + (32 * ks + 8 * fq) * 2);
#pragma unroll
            for (int st = 0; st < 8; ++st) { cb[st] = (f32x4){0.f, 0.f, 0.f, 0.f};
                if (st <= w) {
#pragma unroll
                    for (int ks = 0; ks < 4; ++ks) cb[st] = MFMA16(ld_frag16(Bm + (16 * st + fr) * 272 + (32 * ks + 8 * fq) * 2), cf[ks], cb[st]); } }
        }
#pragma unroll 1
        for (int rr = 0; rr < 3; ++rr) { const int r = 3 * half + rr, hh = 6 * g + r;
            const float al = Acl[r * 128 + lrow], el = __expf(al), Dh = Dskip[hh];
            const gbf* pv = PREV + ((size_t)((b * 32 + c) * 12 + hh)) * 8192;
            f32x4 y[4];
#pragma unroll
            for (int ph2 = 0; ph2 < 2; ++ph2) { bf16x8 pf[2][4];
#pragma unroll
                for (int p2 = 0; p2 < 2; ++p2)
#pragma unroll
                    for (int ks = 0; ks < 4; ++ks) pf[p2][ks] = *(const GAS bf16x8*)(pv + (16 * (2 * ph2 + p2) + fr) * 128 + 32 * ks + 8 * fq);
#pragma unroll
                for (int p2 = 0; p2 < 2; ++p2) { f32x4 acc = {0.f, 0.f, 0.f, 0.f};
#pragma unroll
                    for (int ks = 0; ks < 4; ++ks) acc = MFMA16(pf[p2][ks], cf[ks], acc);
                    y[2 * ph2 + p2] = acc * el; } }
#pragma unroll
            for (int sb = 0; sb < 4; ++sb) {
                if (2 * sb <= w) {
                    const int s0 = 32 * sb + 4 * fq, s1 = s0 + 16;
                    const f32x4 a0 = *(const LAS f32x4*)(Acl + r * 128 + s0), a1 = *(const LAS f32x4*)(Acl + r * 128 + s1);
                    const f32x4 d0 = *(const LAS f32x4*)(dtl + r * 128 + s0), d1 = *(const LAS f32x4*)(dtl + r * 128 + s1);
                    f32x4 g0, g1;
#pragma unroll
                    for (int j = 0; j < 4; ++j) { g0[j] = (dl >= 32 * sb + j) ? cb[2 * sb][j] * __expf(al - a0[j]) * d0[j] : 0.f; g1[j] = (dl >= 32 * sb + 16 + j) ? cb[2 * sb + 1][j] * __expf(al - a1[j]) * d1[j] : 0.f; }
                    const bf16x8 gf = pack_frag(g0, g1);
                    { bf16x8 xf[4];
#pragma unroll
                        for (int pt = 0; pt < 4; ++pt) { const LAS unsigned char* xp = XT + (rr * 64 + 16 * pt + fr) * 272; xf[pt] = ld_frag8x2(xp + s0 * 2, xp + s1 * 2); }
#pragma unroll
                        for (int pt = 0; pt < 4; ++pt) y[pt] = MFMA16(xf[pt], gf, y[pt]); }
                }
            }
#pragma unroll
            for (int pt = 0; pt < 4; ++pt) {
                const u32x2 zw = *(const GAS u32x2*)(PROJ + m * NPJ + PC_SZ + hh * 64 + 16 * pt + 4 * fq);
                f32x4 v = y[pt];
#pragma unroll
                for (int j = 0; j < 4; ++j) v[j] += Dh * bf2f(*(const LAS unsigned short*)(XT + (rr * 64 + 16 * pt + 4 * fq + j) * 272 + 2 * lrow));
                v[0] *= silu_f(bflo(zw.x)); v[1] *= silu_f(bfhi(zw.x)); v[2] *= silu_f(bflo(zw.y)); v[3] *= silu_f(bfhi(zw.y));
                u32x2 o; o.x = pk2(v[0], v[1]); o.y = pk2(v[2], v[3]);
                *(GAS u32x2*)(MIX + m * D + 1280 + hh * 64 + 16 * pt + 4 * fq) = o; }
        }
        __syncthreads();
    }
}

__device__ __forceinline__ void gdn_scan(Frame& F, int bh) {
    const int b = bh / 6, h = bh % 6, fr = F.lane & 15, fq = F.lane >> 4, e0 = 16 * F.wave;
    const gbf* GW = (const gbf*)(F.ws + WS_SCR + SCR_GW) + (size_t)bh * 64 * 8192; const gbf* GQD = (const gbf*)(F.ws + WS_SCR + SCR_GQD) + (size_t)bh * 64 * 8192;
    const gbf* GKDT = (const gbf*)(F.ws + WS_SCR + SCR_GKDT) + (size_t)bh * 64 * 8192; const gbf* GUT = (const gbf*)(F.ws + WS_SCR + SCR_GUT) + (size_t)bh * 64 * 8192;
    const gbf* GQK = (const gbf*)(F.ws + WS_SCR + SCR_GQK) + (size_t)bh * 64 * 4096; const gf32* GDEC = (const gf32*)(F.ws + WS_SCR + SCR_GDEC) + bh * 64;
    gbf* MIX = (gbf*)(F.ws + WS_MIX);
    u32x4 preA[7], preB[7]; u32x2 upreA[4], upreB[4];
#define GS_LOAD(pre, upre, n) do { _Pragma("unroll") for (int i = 0; i < 7; ++i) { const int p = F.tid + NTHR * i; \
        const gbf* src = (i < 2) ? GW + (size_t)(n) * 8192 + 8 * p : (i < 4) ? GQD + (size_t)(n) * 8192 + 8 * (p - 1024) : (i < 6) ? GKDT + (size_t)(n) * 8192 + 8 * (p - 2048) : GQK + (size_t)(n) * 4096 + 8 * (p - 3072); \
        pre[i] = *(const GAS u32x4*)src; } \
        _Pragma("unroll") for (int ct = 0; ct < 4; ++ct) upre[ct] = *(const GAS u32x2*)(GUT + (size_t)(n) * 8192 + (e0 + fr) * 64 + 16 * ct + 4 * fq); } while (0)
#define GS_STORE(pre, buf) do { LAS unsigned char* B_ = F.lds + (buf) * 62464; _Pragma("unroll") for (int i = 0; i < 7; ++i) { const int p = F.tid + NTHR * i; \
        const int off = (i < 2) ? (p >> 4) * 272 + (p & 15) * 16 : (i < 4) ? 17408 + ((p - 1024) >> 4) * 272 + (p & 15) * 16 : (i < 6) ? 34816 + ((p - 2048) >> 3) * 144 + (p & 7) * 16 : 53248 + ((p - 3072) >> 3) * 144 + (p & 7) * 16; \
        *(LAS u32x4*)(B_ + off) = pre[i]; } } while (0)
    f32x4 S[8];
#pragma unroll
    for (int dt = 0; dt < 8; ++dt) S[dt] = (f32x4){0.f, 0.f, 0.f, 0.f};
    u32x2 ucur[4];
    auto chunk = [&](const int n, const int buf) __attribute__((always_inline)) {
        const LAS unsigned char* Bf = F.lds + buf * 62464;
        const float dec = GDEC[n];
        bf16x8 Sb[4];
#pragma unroll
        for (int kb = 0; kb < 4; ++kb) Sb[kb] = pack_frag(S[2 * kb], S[2 * kb + 1]);
        f32x4 vn[4], o[4];
#pragma unroll
        for (int cp = 0; cp < 2; ++cp) { bf16x8 wf[2][4], qf[2][4];
#pragma unroll
            for (int c2 = 0; c2 < 2; ++c2) { const LAS unsigned char* wp = Bf + (16 * (2 * cp + c2) + fr) * 272;
#pragma unroll
                for (int kb = 0; kb < 4; ++kb) { const int o0 = (32 * kb + 4 * fq) * 2; wf[c2][kb] = ld_frag8x2(wp + o0, wp + o0 + 32); } }
#pragma unroll
            for (int c2 = 0; c2 < 2; ++c2) { const LAS unsigned char* qp = Bf + 17408 + (16 * (2 * cp + c2) + fr) * 272;
#pragma unroll
                for (int kb = 0; kb < 4; ++kb) { const int o0 = (32 * kb + 4 * fq) * 2; qf[c2][kb] = ld_frag8x2(qp + o0, qp + o0 + 32); } }
#pragma unroll
            for (int c2 = 0; c2 < 2; ++c2) { const int ct = 2 * cp + c2; f32x4 aw = {0.f, 0.f, 0.f, 0.f}, aq = {0.f, 0.f, 0.f, 0.f};
#pragma unroll
                for (int kb = 0; kb < 4; ++kb) { aw = MFMA16(wf[c2][kb], Sb[kb], aw); aq = MFMA16(qf[c2][kb], Sb[kb], aq); }
                vn[ct] = (f32x4){bflo(ucur[ct].x), bfhi(ucur[ct].x), bflo(ucur[ct].y), bfhi(ucur[ct].y)} - aw; o[ct] = aq; } }
        bf16x8 Vf[2];
#pragma unroll
        for (int sb = 0; sb < 2; ++sb) Vf[sb] = pack_frag(vn[2 * sb], vn[2 * sb + 1]);
        { bf16x8 kq[4][2];
#pragma unroll
            for (int ct = 0; ct < 4; ++ct) { const LAS unsigned char* kp = Bf + 53248 + (16 * ct + fr) * 144;
#pragma unroll
                for (int sb = 0; sb < 2; ++sb) { const int o0 = (32 * sb + 4 * fq) * 2; kq[ct][sb] = ld_frag8x2(kp + o0, kp + o0 + 32); } }
#pragma unroll
            for (int ct = 0; ct < 4; ++ct)
#pragma unroll
                for (int sb = 0; sb < 2; ++sb) o[ct] = MFMA16(kq[ct][sb], Vf[sb], o[ct]); }
#pragma unroll
        for (int dh = 0; dh < 2; ++dh) { bf16x8 kd[4][2];
#pragma unroll
            for (int d4 = 0; d4 < 4; ++d4) { const LAS unsigned char* kp = Bf + 34816 + (16 * (4 * dh + d4) + fr) * 144;
#pragma unroll
                for (int cbk = 0; cbk < 2; ++cbk) { const int o0 = (32 * cbk + 4 * fq) * 2; kd[d4][cbk] = ld_frag8x2(kp + o0, kp + o0 + 32); } }
#pragma unroll
            for (int d4 = 0; d4 < 4; ++d4) { f32x4 acc = S[4 * dh + d4] * dec;
#pragma unroll
                for (int cbk = 0; cbk < 2; ++cbk) acc = MFMA16(kd[d4][cbk], Vf[cbk], acc);
                S[4 * dh + d4] = acc; } }
#pragma unroll
        for (int ct = 0; ct < 4; ++ct)
#pragma unroll
            for (int j = 0; j < 4; ++j) MIX[(size_t)(b * SEQ + 64 * n + 16 * ct + 4 * fq + j) * D + 512 + h * 128 + e0 + fr] = f2bf(o[ct][j]);
    };
    GS_LOAD(preA, upreA, 0); GS_STORE(preA, 0);
#pragma unroll
    for (int ct = 0; ct < 4; ++ct) ucur[ct] = upreA[ct];
    GS_LOAD(preB, upreB, 1);
    __syncthreads();
#pragma unroll 1
    for (int n = 0; n < 64; n += 2) {
        if (n + 2 < 64) GS_LOAD(preA, upreA, n + 2);
        chunk(n, 0);
        GS_STORE(preB, 1);
#pragma unroll
        for (int ct = 0; ct < 4; ++ct) ucur[ct] = upreB[ct];
        __syncthreads();
        if (n + 3 < 64) GS_LOAD(preB, upreB, n + 3);
        chunk(n + 1, 1);
        if (n + 2 < 64) { GS_STORE(preA, 0);
#pragma unroll
            for (int ct = 0; ct < 4; ++ct) ucur[ct] = upreA[ct]; }
        __syncthreads();
    }
#undef GS_LOAD
#undef GS_STORE
}

__device__ __forceinline__ void gdn_post_phase(Frame& F, const gf32* ogain) {
    const gbf* PROJ = (const gbf*)(F.ws + WS_PROJ); gbf* MIX = (gbf*)(F.ws + WS_MIX);
    const int sub = F.tid & 15;
    const f32x4 g0 = *(const GAS f32x4*)(ogain + 8 * sub), g1 = *(const GAS f32x4*)(ogain + 8 * sub + 4);
    for (int task = (F.bx * NTHR + F.tid) >> 4; task < M * GH; task += (F.G * NTHR) >> 4) {
        const int m = task / GH, h = task % GH;
        gbf* p = MIX + (size_t)m * D + 512 + h * 128 + 8 * sub;
        const u32x4 w = *(const u32x4*)p; const u32x4 gz = *(const GAS u32x4*)(PROJ + (size_t)m * NPJ + PC_GGATE + h * 128 + 8 * sub);
        float v[8] = {bflo(w.x), bfhi(w.x), bflo(w.y), bfhi(w.y), bflo(w.z), bfhi(w.z), bflo(w.w), bfhi(w.w)};
        float ss = 0.f;
#pragma unroll
        for (int j = 0; j < 8; ++j) ss += v[j] * v[j];
        ss += shfl_xor_l(ss, 1, F.lane); ss += shfl_xor_l(ss, 2, F.lane); ss += shfl_xor_l(ss, 4, F.lane); ss += shfl_xor_l(ss, 8, F.lane);
        const float r = 1.0f / sqrtf(ss * (1.0f / 128.f) + NORM_EPS);
        const float z[8] = {bflo(gz.x), bfhi(gz.x), bflo(gz.y), bfhi(gz.y), bflo(gz.z), bfhi(gz.z), bflo(gz.w), bfhi(gz.w)};
        const float gg[8] = {g0.x, g0.y, g0.z, g0.w, g1.x, g1.y, g1.z, g1.w};
#pragma unroll
        for (int j = 0; j < 8; ++j) v[j] = v[j] * r * gg[j] * silu_f(z[j]);
        u32x4 o; o.x = pk2(v[0], v[1]); o.y = pk2(v[2], v[3]); o.z = pk2(v[4], v[5]); o.w = pk2(v[6], v[7]);
        *(u32x4*)p = o;
    }
}
__device__ __forceinline__ void ssd_post_phase(Frame& F, const gf32* ngain) {
    gbf* MIX = (gbf*)(F.ws + WS_MIX);
    const int sub = F.tid & 15;
    for (int task = (F.bx * NTHR + F.tid) >> 4; task < M * SG; task += (F.G * NTHR) >> 4) {
        const int m = task >> 1, g = task & 1;
        gbf* p = MIX + (size_t)m * D + 1280 + g * 384 + 8 * sub;
        u32x4 w[3]; float ss = 0.f;
#pragma unroll
        for (int i = 0; i < 3; ++i) { w[i] = *(const GAS u32x4*)(p + 128 * i);
#pragma unroll
            for (int k = 0; k < 4; ++k) { const float a = bflo(w[i][k]), e = bfhi(w[i][k]); ss += a * a + e * e; } }
        ss += shfl_xor_l(ss, 1, F.lane); ss += shfl_xor_l(ss, 2, F.lane); ss += shfl_xor_l(ss, 4, F.lane); ss += shfl_xor_l(ss, 8, F.lane);
        const float r = 1.0f / sqrtf(ss * (1.0f / 384.f) + NORM_EPS);
#pragma unroll
        for (int i = 0; i < 3; ++i) { const gf32* gp = ngain + g * 384 + 128 * i + 8 * sub; const f32x4 g0 = *(const GAS f32x4*)gp, g1 = *(const GAS f32x4*)(gp + 4);
            u32x4 o; o.x = pk2(bflo(w[i].x) * r * g0.x, bfhi(w[i].x) * r * g0.y); o.y = pk2(bflo(w[i].y) * r * g0.z, bfhi(w[i].y) * r * g0.w);
            o.z = pk2(bflo(w[i].z) * r * g1.x, bfhi(w[i].z) * r * g1.y); o.w = pk2(bflo(w[i].w) * r * g1.z, bfhi(w[i].w) * r * g1.w);
            *(GAS u32x4*)(p + 128 * i) = o; }
    }
}

__device__ __forceinline__ void attn_unit(Frame& F, int li, int bh, int qb, const gf32* rel_bias, const gf32* lam4, const gf32* sub_gain) {
    const int b = bh >> 2, h = bh & 3, fr = F.lane & 15, fq = F.lane >> 4, q0 = 128 * qb, mp = F.wave >> 2, wq = F.wave & 3, qw = q0 + 32 * wq;
    const gbf* QN = (const gbf*)(F.ws + WS_SCR + SCR_QN); const gbf* KN = (const gbf*)(F.ws + WS_SCR + SCR_KN); const gbf* VT = (const gbf*)(F.ws + WS_SCR + SCR_VT);
    gbf* MIX = (gbf*)(F.ws + WS_MIX);
    LAS unsigned char* Kl = F.lds;
    LAS unsigned char* Vl = F.lds + 34816;
    LAS float* lut = (LAS float*)(F.lds + 71680);
    if (F.tid < 129) { const int n = F.tid; int bk = n;
        if (n >= 16) { bk = 16 + (n >= 19) + (n >= 21) + (n >= 24) + (n >= 27) + (n >= 31) + (n >= 35) + (n >= 40) + (n >= 46) + (n >= 52) + (n >= 59) + (n >= 67) + (n >= 77) + (n >= 87) + (n >= 99) + (n >= 113); }
        lut[n] = (rel_bias[bk * 4 + h] - rel_bias[31 * 4 + h]) * LOG2E; }
    const float lam_init = 0.8f - 0.6f * __expf(-0.3f * (float)li);
    float lam_full;
    { const float a = lam4[F.lane] * lam4[64 + F.lane], c = lam4[128 + F.lane] * lam4[192 + F.lane];
        lam_full = __expf(wave_sum(a, F.lane)) - __expf(wave_sum(c, F.lane)) + lam_init; }
    bf16x8 Qf[2][2];
#pragma unroll
    for (int qt = 0; qt < 2; ++qt)
#pragma unroll
        for (int ks = 0; ks < 2; ++ks) Qf[qt][ks] = *(const GAS bf16x8*)(QN + (size_t)(b * SEQ + qw + 16 * qt + fr) * 512 + h * 128 + mp * 64 + ks * 32 + fq * 8);
    f32x4 O[2][8];
#pragma unroll
    for (int qt = 0; qt < 2; ++qt)
#pragma unroll
        for (int et = 0; et < 8; ++et) O[qt][et] = (f32x4){0.f, 0.f, 0.f, 0.f};
    float mrun[2] = {-1.0e30f, -1.0e30f}, lrun[2] = {0.f, 0.f};
    const int ntiles = (q0 + 128) >> 6;
    u32x4 pkA[2], pvA[2], pkB[2], pvB[2];
    const gbf* Kg = KN + (size_t)(b * SEQ) * 512 + h * 128; const gbf* Vg = VT + (size_t)(bh * 128) * SEQ;
#define AT_LOAD(pk, pv, t) do { _Pragma("unroll") for (int i = 0; i < 2; ++i) { const int p = F.tid + NTHR * i; \
        pk[i] = *(const GAS u32x4*)(Kg + (size_t)(64 * (t) + (p >> 4)) * 512 + 8 * (p & 15)); pv[i] = *(const GAS u32x4*)(Vg + (size_t)(p >> 3) * SEQ + 64 * (t) + 8 * (p & 7)); } } while (0)
#define AT_STORE(pk, pv, buf) do { _Pragma("unroll") for (int i = 0; i < 2; ++i) { const int p = F.tid + NTHR * i; \
        *(LAS u32x4*)(Kl + (buf) * 17408 + (p >> 4) * 272 + (p & 15) * 16) = pk[i]; *(LAS u32x4*)(Vl + (buf) * 18432 + (p >> 3) * 144 + (p & 7) * 16) = pv[i]; } } while (0)
    const int krow = 8 * (fr >> 2) + (fr & 3);
    auto tile = [&](const int t, const int buf) __attribute__((always_inline)) {
        const int k0 = 64 * t;
        if (k0 <= qw + 31) {
            const bool near = (qw - k0 - 63) < 128;
            const LAS unsigned char* Kb_ = Kl + buf * 17408 + mp * 128; const LAS unsigned char* Vb_ = Vl + buf * 18432;
            f32x4 s[2][2][2];
            { bf16x8 kf[4][2];
#pragma unroll
                for (int ga = 0; ga < 4; ++ga) { const LAS unsigned char* kp = Kb_ + (32 * (ga >> 1) + krow + 4 * (ga & 1)) * 272 + fq * 16; kf[ga][0] = ld_frag16(kp); kf[ga][1] = ld_frag16(kp + 64); }
#pragma unroll
                for (int ga = 0; ga < 4; ++ga)
#pragma unroll
                    for (int qt = 0; qt < 2; ++qt) { f32x4 acc = {0.f, 0.f, 0.f, 0.f}; acc = MFMA16(kf[ga][0], Qf[qt][0], acc); acc = MFMA16(kf[ga][1], Qf[qt][1], acc); s[qt][ga >> 1][ga & 1] = acc; } }
            bf16x8 Pf[2][2];
#pragma unroll
            for (int qt = 0; qt < 2; ++qt) {
                if (near) { const int dbase = qw + 16 * qt + fr - k0 - 8 * fq;
#pragma unroll
                    for (int grp = 0; grp < 2; ++grp)
#pragma unroll
                        for (int ab = 0; ab < 2; ++ab)
#pragma unroll
                            for (int j = 0; j < 4; ++j) { const int dist = dbase - (32 * grp + 4 * ab + j); const int di = dist < 0 ? 0 : (dist > 128 ? 128 : dist); const float bv = lut[di];
                                s[qt][grp][ab][j] = dist < 0 ? -INFINITY : s[qt][grp][ab][j] + bv; }
                }
                float mx = fmaxf(fmaxf(fmaxf(s[qt][0][0][0], s[qt][0][0][1]), fmaxf(s[qt][0][0][2], s[qt][0][0][3])), fmaxf(fmaxf(s[qt][0][1][0], s[qt][0][1][1]), fmaxf(s[qt][0][1][2], s[qt][0][1][3])));
                mx = fmaxf(mx, fmaxf(fmaxf(fmaxf(s[qt][1][0][0], s[qt][1][0][1]), fmaxf(s[qt][1][0][2], s[qt][1][0][3])), fmaxf(fmaxf(s[qt][1][1][0], s[qt][1][1][1]), fmaxf(s[qt][1][1][2], s[qt][1][1][3]))));
                mx = fmaxf(mx, shfl_xor_l(mx, 16, F.lane)); mx = fmaxf(mx, shfl_xor_l(mx, 32, F.lane));
                const float mnew = fmaxf(mrun[qt], mx), alpha = fast_exp2(mrun[qt] - mnew); mrun[qt] = mnew;
                float ps = 0.f;
#pragma unroll
                for (int grp = 0; grp < 2; ++grp)
#pragma unroll
                    for (int ab = 0; ab < 2; ++ab)
#pragma unroll
                        for (int j = 0; j < 4; ++j) { const float p = fast_exp2(s[qt][grp][ab][j] - mnew); s[qt][grp][ab][j] = p; ps += p; }
                lrun[qt] = lrun[qt] * alpha + ps;
                Pf[qt][0] = pack_frag(s[qt][0][0], s[qt][0][1]); Pf[qt][1] = pack_frag(s[qt][1][0], s[qt][1][1]);
#pragma unroll
                for (int et = 0; et < 8; ++et) O[qt][et] = O[qt][et] * alpha;
            }
#pragma unroll
            for (int eh = 0; eh < 2; ++eh) { bf16x8 vf[4][2];
#pragma unroll
                for (int e4 = 0; e4 < 4; ++e4) { const LAS unsigned char* vp = Vb_ + (16 * (4 * eh + e4) + fr) * 144 + (8 * fq) * 2; vf[e4][0] = ld_frag16(vp); vf[e4][1] = ld_frag16(vp + 64); }
#pragma unroll
                for (int e4 = 0; e4 < 4; ++e4)
#pragma unroll
                    for (int qt = 0; qt < 2; ++qt) { f32x4 acc = O[qt][4 * eh + e4]; acc = MFMA16(vf[e4][0], Pf[qt][0], acc); acc = MFMA16(vf[e4][1], Pf[qt][1], acc); O[qt][4 * eh + e4] = acc; } }
        }
    };
    AT_LOAD(pkA, pvA, 0); AT_STORE(pkA, pvA, 0); AT_LOAD(pkB, pvB, 1);
    __syncthreads();
#pragma unroll 1
    for (int t = 0; t < ntiles; t += 2) {
        if (t + 2 < ntiles) AT_LOAD(pkA, pvA, t + 2);
        tile(t, 0);
        AT_STORE(pkB, pvB, 1);
        __syncthreads();
        if (t + 3 < ntiles) AT_LOAD(pkB, pvB, t + 3);
        tile(t + 1, 1);
        if (t + 2 < ntiles) AT_STORE(pkA, pvA, 0);
        __syncthreads();
    }
#undef AT_LOAD
#undef AT_STORE
#pragma unroll
    for (int qt = 0; qt < 2; ++qt) { float l = lrun[qt]; l += shfl_xor_l(l, 16, F.lane); l += shfl_xor_l(l, 32, F.lane); const float sc = (mp ? lam_full : 1.0f) / l;
#pragma unroll
        for (int et = 0; et < 8; ++et) O[qt][et] = O[qt][et] * sc; }
    LAS f32x4* X = (LAS f32x4*)F.lds + (wq * 16) * 64 + F.lane;
    if (mp == 1) {
#pragma unroll
        for (int qt = 0; qt < 2; ++qt)
#pragma unroll
            for (int et = 0; et < 8; ++et) X[(qt * 8 + et) * 64] = O[qt][et]; }
    __syncthreads();
    if (mp == 0) {
#pragma unroll
        for (int qt = 0; qt < 2; ++qt) { float ss = 0.f;
#pragma unroll
            for (int et = 0; et < 8; ++et) { const f32x4 v = O[qt][et] - X[(qt * 8 + et) * 64]; O[qt][et] = v; ss += (v[0] * v[0] + v[1] * v[1]) + (v[2] * v[2] + v[3] * v[3]); }
            ss += shfl_xor_l(ss, 16, F.lane); ss += shfl_xor_l(ss, 32, F.lane);
            const float rs = (1.0f / sqrtf(ss * (1.0f / 128.f) + NORM_EPS)) * (1.0f - lam_init);
            gbf* dst = MIX + (size_t)(b * SEQ + qw + 16 * qt + fr) * D + h * 128 + 4 * fq;
#pragma unroll
            for (int et = 0; et < 8; ++et) { const f32x4 gn = *(const GAS f32x4*)(sub_gain + 16 * et + 4 * fq); const f32x4 v = O[qt][et] * rs * gn;
                u32x2 o; o.x = pk2(v[0], v[1]); o.y = pk2(v[2], v[3]); *(GAS u32x2*)(dst + 16 * et) = o; } }
    }
    __syncthreads();
}

__global__ void __launch_bounds__(NTHR, 2) fwd_kernel(Args args) {
    extern __shared__ __attribute__((aligned(16))) unsigned char lds_raw[];
    Frame F;
    F.lds = (LAS unsigned char*)lds_raw;
    F.MISC = (volatile LAS unsigned*)(F.lds + MISC_OFF);
    F.tid = threadIdx.x; F.lane = F.tid & 63; F.wave = __builtin_amdgcn_readfirstlane(F.tid >> 6);
    F.G = gridDim.x; F.bx = blockIdx.x; F.ws = (GAS unsigned char*)args.ws;
    F.ctl = (gu32*)((GAS unsigned char*)args.ws + WS_CTL);
    for (int u = F.tid; u < (LDS_BYTES - LDSCTL_OFF) / 4; u += NTHR) ((LAS unsigned*)(F.lds + LDSCTL_OFF))[u] = 0u;
    __syncthreads();
    const int wave_s = __builtin_amdgcn_readfirstlane(threadIdx.x >> 6);
    XcdBarrier bar = xcd_barrier_post((unsigned*)(F.ctl + CW_BAR), F.MISC + 8);
    const int lo = args.ph_lo, hi = args.ph_hi;
    int ph = 0;
#define RELAUNDER() do { int _wv = wave_s; asm volatile("" : "+s"(_wv)); unsigned _z = 0u; asm volatile("" : "+v"(_z)); int _t = _wv * 64 + (int)__builtin_amdgcn_mbcnt_hi(~0u, __builtin_amdgcn_mbcnt_lo(~0u, _z)); asm volatile("" : "+v"(_t)); \
        F.tid = _t; F.lane = _t & 63; F.wave = _wv; \
        int _g = gridDim.x; asm volatile("" : "+s"(_g)); F.G = _g; int _b = blockIdx.x; asm volatile("" : "+s"(_b)); F.bx = _b; \
        unsigned char* _w = args.ws; asm volatile("" : "+s"(_w)); F.ws = (GAS unsigned char*)_w; } while (0)
#ifndef DUPMASK
#define DUPMASK 0
#endif
#ifndef DUPG
#define DUPG 0
#endif
#define PHASE_BEGIN(id) if (lo <= ph && ph < hi) { RELAUNDER(); int nrep_ = 1; if ((DUPMASK >> (id)) & 1) { nrep_ = 2; asm volatile("" : "+s"(nrep_)); } _Pragma("unroll 1") for (int rep_ = 0; rep_ < nrep_; ++rep_) {
#ifndef DUPBAR
#define DUPBAR 0
#endif
#define PHASE_END   } if (ph + 1 < hi) { XcdBarrier _b2 = bar; asm volatile("" : "+s"(_b2.x), "+s"(_b2.bar)); xcd_barrier(_b2); if (DUPBAR) { asm volatile("" : "+s"(_b2.x), "+s"(_b2.bar)); xcd_barrier(_b2); } } } ++ph;

#define ARGP(k) ({ const Args* _kp = (const Args*)__builtin_amdgcn_kernarg_segment_ptr(); asm volatile("" : "+s"(_kp)); (const gf32*)_kp->in[k]; })
    gf32* const xout = (gf32*)args.out;

    PHASE_BEGIN(0) { p0_prologue(F, args); norm_phase<false, false>(F, ARGP(0), ARGP(2), (gbf*)(F.ws + WS_H), nullptr); } PHASE_END

    int nlayers = 2; asm volatile("" : "+s"(nlayers));
#pragma unroll 1
    for (int li = 0; li < nlayers; ++li) {
        if (li != 0) { PHASE_BEGIN(1) norm_phase<false, false>(F, (const gf32*)xout, ARGP(2) + li * D, (gbf*)(F.ws + WS_H), nullptr); PHASE_END }
        PHASE_BEGIN(2) {
            pg8::Gemm g{(const gbf*)(F.ws + WS_H), (const gbf*)(F.ws + WS_WIN + li * SZ_WIN), D, 0, 0}; pg8::StaticOrder S; S.init(M, NPJ, F.G, F.bx);
            pg8::EpiProj E{(gbf*)(F.ws + WS_PROJ), (gf32*)(F.ws + WS_SMALL)};
            pg8::gemm_phase<pg8::EpiProj, pg8::StaticOrder>(F.lds, g, S, E, F.tid);
        } PHASE_END
        PHASE_BEGIN(3) {
#pragma unroll 1
            for (int u = F.bx; u < 1280; u += F.G) {
                RELAUNDER();
#ifndef DUPA
#define DUPA 0
#endif
                if (u < 256) { attn_prep_unit(F, u, ARGP(4) + li * 64, ARGP(5) + li * 64); if (DUPA & 1) attn_prep_unit(F, u, ARGP(4) + li * 64, ARGP(5) + li * 64); }
                else if (u < 1024) { gdn_prep_unit(F, u - 256, ARGP(8) + li * 4 * 2304, ARGP(9) + li * 6, ARGP(10) + li * 6); if (DUPA & 2) gdn_prep_unit(F, u - 256, ARGP(8) + li * 4 * 2304, ARGP(9) + li * 6, ARGP(10) + li * 6); }
                else { ssd_state_unit(F, u - 1024, ARGP(12) + li * 4 * SXBC, ARGP(13) + li * SXBC, ARGP(14) + li * 12, ARGP(15) + li * 12); if (DUPA & 4) ssd_state_unit(F, u - 1024, ARGP(12) + li * 4 * SXBC, ARGP(13) + li * SXBC, ARGP(14) + li * 12, ARGP(15) + li * 12); }
            }
        } PHASE_END
        PHASE_BEGIN(4) ssd_scan_phase(F); PHASE_END
        PHASE_BEGIN(5) {
#ifndef DUPC
#define DUPC 0
#endif
            if (F.bx < BATCH * GH) { gdn_scan(F, F.bx); if (DUPC & 1) gdn_scan(F, F.bx); }
            LAS int* qslot = (LAS int*)(F.lds + LDSCTL_OFF);
            constexpr unsigned CONV_LIMIT = 96;
            unsigned* const compq = (unsigned*)(F.ctl + CW_QUEUE + 64 * li + 128 * rep_); unsigned* const convq = (unsigned*)(F.ctl + CW_QUEUE + 512 + 128 * rep_); unsigned* const active = (unsigned*)(F.ctl + CW_QUEUE + 576);
#pragma unroll 1
            for (;;) {
                if (F.tid == 0) { int kind = -1, unit = 0;
                    if (li == 0) { const unsigned a = __hip_atomic_fetch_add(active, 1u, __ATOMIC_RELAXED, __HIP_MEMORY_SCOPE_AGENT);
                        if (a < CONV_LIMIT) { const unsigned c = __hip_atomic_fetch_add(convq, 1u, __ATOMIC_RELAXED, __HIP_MEMORY_SCOPE_AGENT); if (c < (unsigned)N_DEF_UNITS) { kind = 1; unit = (int)c; } }
                        if (kind < 0) __hip_atomic_fetch_sub(active, 1u, __ATOMIC_RELAXED, __HIP_MEMORY_SCOPE_AGENT); }
                    if (kind < 0) { const unsigned q = __hip_atomic_fetch_add(compq, 1u, __ATOMIC_RELAXED, __HIP_MEMORY_SCOPE_AGENT); if (q < 768u) { kind = 0; unit = (int)q; } }
                    if (kind < 0 && li == 0) { const unsigned c = __hip_atomic_fetch_add(convq, 1u, __ATOMIC_RELAXED, __HIP_MEMORY_SCOPE_AGENT); if (c < (unsigned)N_DEF_UNITS) { kind = 2; unit = (int)c; } }
                    qslot[0] = kind; qslot[1] = unit; }
                __syncthreads();
                const int kind = qslot[0], qi = qslot[1];
                __syncthreads();
                if (kind < 0) break;
                RELAUNDER();
                if (kind > 0) { LAS float* scr = (LAS float*)(F.lds) + F.wave * (64 * 65);
                    const CvSrc src{ARGP(3), ARGP(18), ARGP(20), ARGP(21), ARGP(22), ARGP(24), ARGP(25), ARGP(26)};
                    cv_run(F, qi * 64 + 2 * F.wave, 16, 4, [](int d) { return def_item(d); }, src, scr);
                    __syncthreads();
                    if (kind == 1 && F.tid == 0) __hip_atomic_fetch_sub(active, 1u, __ATOMIC_RELAXED, __HIP_MEMORY_SCOPE_AGENT);
                    continue; }
                const int au = qi < 304 ? qi : (qi >= 560 ? qi - 256 : -1);
                if (au >= 0) attn_unit(F, li, au & 15, 31 - (au >> 4), ARGP(1), ARGP(6) + li * 256, ARGP(7) + li * 128);
                else ssd_out_unit(F, qi - 304, ARGP(12) + li * 4 * SXBC, ARGP(13) + li * SXBC, ARGP(14) + li * 12, ARGP(15) + li * 12, ARGP(16) + li * 12);
            }
        } PHASE_END
        PHASE_BEGIN(6) { gdn_post_phase(F, ARGP(11) + li * 128); ssd_post_phase(F, ARGP(17) + li * SW); } PHASE_END
        PHASE_BEGIN(7) { const gf32* xin = (li == 0) ? ARGP(0) : (const gf32*)xout;
            pg8::Gemm g{(const gbf*)(F.ws + WS_MIX), (const gbf*)(F.ws + WS_WOUT + li * SZ_WOUT), D, 0, 0}; pg8::StaticOrder S; S.init(M, D, F.G, F.bx);
            pg8::EpiResF32 E{xin, xout, D};
            pg8::gemm_phase<pg8::EpiResF32, pg8::StaticOrder>(F.lds, g, S, E, F.tid);
        } PHASE_END
        PHASE_BEGIN(8) {
            if (li == 0) norm_phase<false, DENSE_GU_F8 != 0>(F, xout, ARGP(19) + li * D, (gbf*)(F.ws + WS_H), nullptr);
            else norm_phase<true, true>(F, xout, ARGP(19) + li * D, (gbf*)(F.ws + WS_H), ARGP(23));
        } PHASE_END
        PHASE_BEGIN(9) {
            if (li == 0) { if (F.bx == 0 && F.tid < 64) { gi32* tab = (gi32*)(F.ws + WS_ROUTE + RT_TABD); const int z = F.tid >> 9; if (F.tid == 0) tab[0] = 64 + z;
                tab[4 + 4 * F.tid] = z; tab[5 + 4 * F.tid] = 256 * F.tid; tab[6 + 4 * F.tid] = 256 + z; tab[7 + 4 * F.tid] = z; } }
            else route_phase(F);
        } PHASE_END
        PHASE_BEGIN(10) {
            if (li == 0) {
                pg8::Gemm g{(const gbf*)(F.ws + WS_H), (const gbf*)(F.ws + WS_WGU), D, SC_ONE, SC_W8};
                pg8::MoeOrder S{(const gi32*)(F.ws + WS_ROUTE + RT_TABD), 2 * DFF / 256, F.G, F.bx, 2 * DFF};
                pg8::EpiSwiglu<false> E{(gbf*)(F.ws + WS_ACT), (const gf32*)nullptr};
                int nr2 = 1; if (DUPG & 4) { nr2 = 2; asm volatile("" : "+s"(nr2)); }
#pragma unroll 1
                for (int r2 = 0; r2 < nr2; ++r2)
                pg8::gemm_phase<pg8::EpiSwiglu<false>, pg8::MoeOrder, DENSE_GU_F8 != 0>(F.lds, g, S, E, F.tid);
            } else {
                pg8::Gemm g{(const gbf*)(F.ws + WS_HG), (const gbf*)(F.ws + WS_MGU), D, SC_ONE, SC_W8};
                pg8::MoeOrder S{(const gi32*)(F.ws + WS_ROUTE + RT_TAB), 2 * DFF / 256, F.G, F.bx, 2 * DFF};
                pg8::EpiSwiglu<true> E{(gbf*)(F.ws + WS_ACTM), (const gf32*)(F.ws + WS_ROUTE + RT_SW)};
                int nr2 = 1; if (DUPG & 1) { nr2 = 2; asm volatile("" : "+s"(nr2)); }
#pragma unroll 1
                for (int r2 = 0; r2 < nr2; ++r2)
                pg8::gemm_phase<pg8::EpiSwiglu<true>, pg8::MoeOrder, true>(F.lds, g, S, E, F.tid);
            }
        } PHASE_END
        PHASE_BEGIN(11) {
            if (li == 0) {
                pg8::Gemm g{(const gbf*)(F.ws + WS_ACT), (const gbf*)(F.ws + WS_WDN), DFF, 0, 0};
                pg8::MoeOrder S{(const gi32*)(F.ws + WS_ROUTE + RT_TABD), D / 256, F.G, F.bx, D};
                pg8::EpiDown E{xout, (gbf*)nullptr};
                pg8::gemm_phase<pg8::EpiDown, pg8::MoeOrder, false>(F.lds, g, S, E, F.tid);
            } else {
                pg8::Gemm g{(const gbf*)(F.ws + WS_ACTM), (const gbf*)(F.ws + WS_MDN), DFF, SC_ACT8, SC_W8};
                pg8::MoeOrder S{(const gi32*)(F.ws + WS_ROUTE + RT_TAB), D / 256, F.G, F.bx, D};
                pg8::EpiDown E{xout, (gbf*)(F.ws + WS_HG)};
                int nr2 = 1; if (DUPG & 2) { nr2 = 2; asm volatile("" : "+s"(nr2)); }
#pragma unroll 1
                for (int r2 = 0; r2 < nr2; ++r2)
                pg8::gemm_phase<pg8::EpiDown, pg8::MoeOrder, true>(F.lds, g, S, E, F.tid);
            }
        } PHASE_END
    }
    PHASE_BEGIN(12) {
        const gi32* tpos = (const gi32*)(F.ws + WS_ROUTE + RT_TPOS); const gbf* Y = (const gbf*)(F.ws + WS_HG);
        const int stride = F.G * NTHR;
#pragma unroll 1
        for (int i0 = F.bx * NTHR + F.tid; i0 < M * (D / 8); i0 += 4 * stride) {
            int p1[4], p2[4]; u32x4 ya[4], yb[4]; f32x4 o0[4], o1[4];
#pragma unroll
            for (int u = 0; u < 4; ++u) { const int i = i0 + u * stride; const int t = (i < M * (D / 8)) ? (i >> 8) : 0; p1[u] = tpos[2 * t]; p2[u] = tpos[2 * t + 1]; }
#pragma unroll
            for (int u = 0; u < 4; ++u) { const int i = i0 + u * stride; const int ii = (i < M * (D / 8)) ? i : 0; const int t = ii >> 8, c8 = ii & 255;
                ya[u] = *(const GAS u32x4*)(Y + (size_t)p1[u] * D + 8 * c8); yb[u] = *(const GAS u32x4*)(Y + (size_t)p2[u] * D + 8 * c8);
                const gf32* o = xout + (size_t)t * D + 8 * c8; o0[u] = *(const GAS f32x4*)o; o1[u] = *(const GAS f32x4*)(o + 4); }
#pragma unroll
            for (int u = 0; u < 4; ++u) { const int i = i0 + u * stride; if (i < M * (D / 8)) { const int t = i >> 8, c8 = i & 255; const u32x4 a = ya[u], b = yb[u]; f32x4 q0 = o0[u], q1 = o1[u];
                q0.x += bflo(a.x) + bflo(b.x); q0.y += bfhi(a.x) + bfhi(b.x); q0.z += bflo(a.y) + bflo(b.y); q0.w += bfhi(a.y) + bfhi(b.y);
                q1.x += bflo(a.z) + bflo(b.z); q1.y += bfhi(a.z) + bfhi(b.z); q1.z += bflo(a.w) + bflo(b.w); q1.w += bfhi(a.w) + bfhi(b.w);
                gf32* o = xout + (size_t)t * D + 8 * c8; *(GAS f32x4*)o = q0; *(GAS f32x4*)(o + 4) = q1; } }
        }
    } PHASE_END
#undef ARGP
#undef RELAUNDER
#undef PHASE_BEGIN
#undef PHASE_END
}

#ifndef N_LAUNCHES
#define N_LAUNCHES 1
#endif
extern "C" void kernel_launch(void* const* d_in, const int* in_sizes, int n_in, void* d_out, int out_size, void* d_ws, size_t ws_size, hipStream_t stream) {
    static int grid = 0;
    if (grid == 0) {
        if (n_in != 27 || out_size != M * D || ws_size < WS_NEED) { fprintf(stderr, "kernel_launch: unexpected shapes: n_in %d out %d ws %zu (need %zu)\n", n_in, out_size, ws_size, (size_t)WS_END_MOE); grid = -1; return; }
        int dev = 0, cus = 0, per_cu = 0;
        if (hipGetDevice(&dev) != hipSuccess || hipDeviceGetAttribute(&cus, hipDeviceAttributeMultiprocessorCount, dev) != hipSuccess) { grid = -1; return; }
        if (hipFuncSetAttribute((const void*)fwd_kernel, hipFuncAttributeMaxDynamicSharedMemorySize, LDS_BYTES) != hipSuccess) { fprintf(stderr, "kernel_launch: hipFuncSetAttribute failed\n"); grid = -1; return; }
        if (hipOccupancyMaxActiveBlocksPerMultiprocessor(&per_cu, (const void*)fwd_kernel, NTHR, LDS_BYTES) != hipSuccess || per_cu < 1) { fprintf(stderr, "kernel_launch: occupancy query says %d\n", per_cu); }
        (void)hipGetLastError();
        grid = cus;
    }
    if (grid < 0) return;
    (void)hipMemsetAsync((char*)d_ws + WS_CTL, 0, CTL_ZERO_BYTES, stream);
    Args a{};
    for (int i = 0; i < 27; ++i) a.in[i] = (const float*)d_in[i];
    a.out = (float*)d_out; a.ws = (unsigned char*)d_ws;
    constexpr int NPH = 23;
#if N_LAUNCHES == 1
    a.ph_lo = 0; a.ph_hi = NPH;
    hipLaunchKernelGGL(fwd_kernel, dim3(grid), dim3(NTHR), LDS_BYTES, stream, a);
#else
    for (int p = 0; p < 24; ++p) { a.ph_lo = p; a.ph_hi = p + 1; hipLaunchKernelGGL(fwd_kernel, dim3(grid), dim3(NTHR), LDS_BYTES, stream, a); }
#endif
}
```

```cpp
#include <hip/hip_runtime.h>
#include <cstdio>
#include <cstdint>

#define LAS __attribute__((address_space(3)))
#define GAS __attribute__((address_space(1)))
typedef unsigned short bf16;
typedef short bf16x8 __attribute__((ext_vector_type(8)));
typedef short s16x4 __attribute__((ext_vector_type(4)));
typedef float f32x4 __attribute__((ext_vector_type(4)));
typedef float f32x2 __attribute__((ext_vector_type(2)));
typedef unsigned u32x4 __attribute__((ext_vector_type(4)));
typedef unsigned u32x2 __attribute__((ext_vector_type(2)));
typedef GAS unsigned gu32;
typedef GAS unsigned short gbf;
typedef GAS float gf32;
typedef GAS int gi32;

constexpr int BATCH = 4, SEQ = 4096, M = BATCH * SEQ, D = 2048, DIN = 6680, NPJ = 6912, DFF = 5632, NE = 8;
constexpr int AH = 4, AW = 512;
constexpr int GH = 6, GD = 128, GW = 768, GC = 64;
constexpr int SH = 12, SP = 64, SG = 2, SN = 128, SW = 768, SXBC = 1280, SL = 128;
constexpr float NORM_EPS = 1e-6f;
constexpr int PC_AQ = 0, PC_AK = 512, PC_AV = 1024, PC_GQKV = 1536, PC_GGATE = 3840, PC_SZ = 4608, PC_SXBC = 5376, PC_SMALL = 6656;

constexpr size_t MiB = 1u << 20;
constexpr size_t WS_CTL = 0, CTL_ZERO_BYTES = 1 * MiB;
constexpr size_t SZ_WIN = (size_t)NPJ * D * 2, SZ_WOUT = (size_t)D * D * 2, SZ_WGU = (size_t)2 * DFF * D * 2, SZ_WDN = (size_t)D * DFF * 2;
constexpr size_t WS_WIN = 2 * MiB;
constexpr size_t WS_WOUT = WS_WIN + 2 * SZ_WIN;
constexpr size_t WS_WGU = WS_WOUT + 2 * SZ_WOUT;
constexpr size_t WS_WDN = WS_WGU + SZ_WGU;
constexpr size_t WS_MGU = WS_WDN + SZ_WDN;
constexpr size_t WS_MDN = WS_MGU + NE * SZ_WGU;
constexpr size_t WS_H = WS_MDN + NE * SZ_WDN;
constexpr size_t WS_SMALL = WS_H + (size_t)M * D * 2;
constexpr size_t WS_ROUTE = WS_SMALL + (size_t)M * 32 * 4;
constexpr size_t WS_BIG = WS_ROUTE + 2 * MiB;
constexpr size_t WS_PROJ = WS_BIG;
constexpr size_t WS_MIX = WS_PROJ + (size_t)M * NPJ * 2;
constexpr size_t WS_SCR = WS_MIX + (size_t)M * D * 2;
constexpr size_t WS_ACT = WS_BIG;
constexpr size_t WS_HG = WS_BIG;
constexpr size_t WS_ACTM = WS_HG + (size_t)(2 * M + 256) * D * 2;
constexpr size_t WS_END_MOE = WS_ACTM + (size_t)(2 * M + 256) * DFF * 2;

constexpr size_t RT_TOKE = 0;
constexpr size_t RT_TOKW = RT_TOKE + M * 4;
constexpr size_t RT_WGCNT = RT_TOKW + M * 8;
constexpr size_t RT_STOK = RT_WGCNT + 1024 * 8 * 4;
constexpr size_t RT_SW = RT_STOK + (2 * M + 256) * 4;
constexpr size_t RT_TAB = RT_SW + (2 * M + 256) * 4;
constexpr size_t RT_TABD = RT_TAB + 4096;
constexpr size_t RT_TPOS = RT_TABD + 4096;
static_assert(RT_TPOS + M * 8 <= 2 * MiB, "route tables");

constexpr int CW_TMO = 0, CW_CODE = 1, CW_BAR = 4096, CW_QUEUE = 16384;

constexpr int RING_BYTES = 143360;
constexpr int LDSCTL_OFF = RING_BYTES, MISC_OFF = LDSCTL_OFF + 256;
constexpr int LDS_BYTES = 147456;

constexpr int NWAVES = 8, NTHR = 512;

#define RLX_AGENT __ATOMIC_RELAXED, __HIP_MEMORY_SCOPE_AGENT
#define LDS_WAIT() asm volatile("s_waitcnt lgkmcnt(0)" ::: "memory")
#define VM_WAIT() asm volatile("s_waitcnt vmcnt(0)" ::: "memory")
__device__ __forceinline__ float bf2f(unsigned short b) { return __uint_as_float(((unsigned)b) << 16); }
__device__ __forceinline__ float bflo(unsigned w) { return __uint_as_float(w << 16); }
__device__ __forceinline__ float bfhi(unsigned w) { return __uint_as_float(w & 0xffff0000u); }
typedef __bf16 bf16x2_t __attribute__((ext_vector_type(2)));
__device__ __forceinline__ unsigned pk2(float lo, float hi) { f32x2 v = {lo, hi}; bf16x2_t b = __builtin_convertvector(v, bf16x2_t); return __builtin_bit_cast(unsigned, b); }
__device__ __forceinline__ unsigned short f2bf(float f) { return (unsigned short)(pk2(f, 0.f) & 0xffffu); }
__device__ __forceinline__ float shfl_xor_l(float v, int o, int lane) { return __builtin_bit_cast(float, __builtin_amdgcn_ds_bpermute((lane ^ o) << 2, __builtin_bit_cast(int, v))); }
__device__ __forceinline__ unsigned pk4_fp8(float a, float b, float c, float d) {
#if defined(__HIP_DEVICE_COMPILE__)
    int w = __builtin_amdgcn_cvt_pk_fp8_f32(a, b, 0, false); w = __builtin_amdgcn_cvt_pk_fp8_f32(c, d, w, true); return (unsigned)w;
#else
    return 0u;
#endif
}
__device__ __forceinline__ float sat8(float x) { return __builtin_fminf(__builtin_fmaxf(x, -448.0f), 448.0f); }
__device__ __forceinline__ unsigned pk4_fp8_sat(float a, float b, float c, float d) { return pk4_fp8(sat8(a), sat8(b), sat8(c), sat8(d)); }
typedef int v8i32 __attribute__((ext_vector_type(8)));
typedef int v4i32 __attribute__((ext_vector_type(4)));
#ifndef DENSE_GU_F8
#define DENSE_GU_F8 1
#endif
#ifndef DENSE_DN_F8
#define DENSE_DN_F8 1
#endif
constexpr float W8_SCALE = 64.0f, ACT8_SCALE = 8.0f;
constexpr int SC_ONE = 0x7f7f7f7f, SC_W8 = 0x79797979, SC_ACT8 = 0x7c7c7c7c;
__device__ __forceinline__ float wave_sum(float v, int lane) {
#pragma unroll
    for (int o = 1; o < 64; o <<= 1) v += shfl_xor_l(v, o, lane);
    return v;
}
__device__ __forceinline__ float fast_exp2(float x) { return __builtin_amdgcn_exp2f(x); }
__device__ __forceinline__ float fast_rcp(float x) { return __builtin_amdgcn_rcpf(x); }
__device__ __forceinline__ float silu_f(float g) { return g * fast_rcp(1.0f + fast_exp2(-1.4426950408889634f * g)); }
__device__ __forceinline__ float sigmoid_f(float g) { return 1.0f / (1.0f + __expf(-g)); }
__device__ __forceinline__ float softplus_f(float x) { const float e = __expf(x); return x > 15.f ? x : (e < 4.0e-4f ? e * (1.0f - 0.5f * e) : __logf(1.0f + e)); }

__device__ __forceinline__ void gatomic_add(gf32* p, float v) {
#if defined(__HIP_DEVICE_COMPILE__)
    (void)__builtin_amdgcn_global_atomic_fadd_f32(p, v);
#endif
}
namespace pg8 {
constexpr int BM = 256, BK = 64, HALF = 128, HTB = HALF * BK * 2, STAGE_BYTES = 8 * HTB, NXCD = 8, WGM = 8;
__host__ __device__ __forceinline__ int lds_byte(int r, int c) { const int st = (r >> 4) * 2 + (c >> 5), rr = r & 15, cc = c & 31, ob = rr * 64 + cc * 2; return st * 1024 + (ob ^ (((ob >> 9) & 1) << 5)); }
__host__ __device__ __forceinline__ void stage_rc(int b, int& R, int& C) { const int st = b / 1024, sb = b % 1024, swz = sb ^ (((sb >> 9) & 1) << 5); R = (st >> 1) * 16 + swz / 64; C = (st & 1) * 32 + (swz % 64) / 2; }
__host__ __device__ __forceinline__ int perm32(int rho) { const int n = rho >> 4, i = rho & 15; return 8 * (i >> 2) + 4 * n + (i & 3); }

struct Unit { int arow, brow, pn, nvalid; };
struct Gemm { const gbf* A; const gbf* Bt; int K; int sca, scb; };

struct StaticOrder {
    int nM, nN, nwg, G, c;
    __device__ void init(int Mr, int N, int G_, int c_) { nM = Mr / BM; nN = N / BM; nwg = nM * nN; G = G_; c = c_; }
    __device__ bool next(int i, Unit& u) const {
        const long L = (long)i * G + c; if (L >= nwg) return false;
        int wgid = (int)L; { const int q = nwg / NXCD, r = nwg % NXCD, xcd = wgid % NXCD, off = wgid / NXCD; wgid = (xcd < r ? xcd * (q + 1) : r * (q + 1) + (xcd - r) * q) + off; }
        const int nig = WGM * nN, gid = wgid / nig, fm = gid * WGM, gsz = (nM - fm) < WGM ? (nM - fm) : WGM;
        const int pm = fm + ((wgid % nig) % gsz), pn = (wgid % nig) / gsz;
        u.arow = pm * BM; u.brow = pn * BM; u.pn = pn; u.nvalid = BM; return true;
    }
};
struct MoeOrder {
    const gi32* tab; int nN, G, c, nexp_rows;
    __device__ bool next(int i, Unit& u) const {
        const int nM = tab[0]; const int nwg = nM * nN;
        const long L = (long)i * G + c; if (L >= nwg) return false;
        int wgid = (int)L; { const int q = nwg / NXCD, r = nwg % NXCD, xcd = wgid % NXCD, off = wgid / NXCD; wgid = (xcd < r ? xcd * (q + 1) : r * (q + 1) + (xcd - r) * q) + off; }
        const int nig = WGM * nN, gid = wgid / nig, fm = gid * WGM, gsz = (nM - fm) < WGM ? (nM - fm) : WGM;
        const int pm = fm + ((wgid % nig) % gsz), pn = (wgid % nig) / gsz;
        const int e = tab[4 + 4 * pm];
        u.arow = tab[5 + 4 * pm]; u.brow = e * nexp_rows + pn * BM; u.pn = pn; u.nvalid = tab[6 + 4 * pm]; return true;
    }
};

struct EpiProj {
    static constexpr bool PERM = true;
    gbf* O; gf32* small;
    __device__ __forceinline__ void operator()(const f32x4 (&acc)[2][2][4][2], const Unit& u, int wr, int wc, int fr, int fq) const {
        const int row0 = u.arow + wr * 64 + fr;
        if (u.pn < 26) {
            const int col0 = u.pn * BM + wc * 32 + 8 * fq;
#pragma unroll
            for (int ai = 0; ai < 2; ++ai)
#pragma unroll
                for (int m = 0; m < 4; ++m) { gbf* rowp = O + (size_t)(row0 + ai * HALF + m * 16) * NPJ + col0;
#pragma unroll
                    for (int bj = 0; bj < 2; ++bj) { const f32x4 v0 = acc[ai][bj][m][0], v1 = acc[ai][bj][m][1];
                        u32x4 w; w.x = pk2(v0[0], v0[1]); w.y = pk2(v0[2], v0[3]); w.z = pk2(v1[0], v1[1]); w.w = pk2(v1[2], v1[3]);
                        *(GAS u32x4*)(rowp + bj * HALF) = w; } }
        } else if (wc == 0) {
#pragma unroll
            for (int ai = 0; ai < 2; ++ai)
#pragma unroll
                for (int m = 0; m < 4; ++m) { gf32* rowp = small + (size_t)(row0 + ai * HALF + m * 16) * 32 + 8 * fq;
                    *(GAS f32x4*)(rowp) = acc[ai][0][m][0]; *(GAS f32x4*)(rowp + 4) = acc[ai][0][m][1]; }
        }
    }
};
struct EpiResF32 {
    static constexpr bool PERM = false;
    const gf32* res; gf32* out; int ldc;
    __device__ __forceinline__ void operator()(const f32x4 (&acc)[2][2][4][2], const Unit& u, int wr, int wc, int fr, int fq) const {
        const int row0 = u.arow + wr * 64 + fr, col0 = u.pn * BM + wc * 32 + 4 * fq;
#pragma unroll
        for (int ai = 0; ai < 2; ++ai)
#pragma unroll
            for (int m = 0; m < 4; ++m) { const size_t off = (size_t)(row0 + ai * HALF + m * 16) * ldc + col0;
#pragma unroll
                for (int bj = 0; bj < 2; ++bj)
#pragma unroll
                    for (int n = 0; n < 2; ++n) { const f32x4 r = *(const GAS f32x4*)(res + off + bj * HALF + n * 16); *(GAS f32x4*)(out + off + bj * HALF + n * 16) = r + acc[ai][bj][m][n]; }
                asm volatile("" ::: "memory"); }
    }
};
template <bool F8> struct EpiSwiglu {
    static constexpr bool PERM = true;
    gbf* O; const gf32* sw;
    __device__ __forceinline__ void operator()(const f32x4 (&acc)[2][2][4][2], const Unit& u, int wr, int wc, int fr, int fq) const {
        const int lr0 = wr * 64 + fr, col0 = u.pn * HALF + wc * 32 + 8 * fq;
#pragma unroll
        for (int ai = 0; ai < 2; ++ai)
#pragma unroll
            for (int m = 0; m < 4; ++m) { const int lr = lr0 + ai * HALF + m * 16;
                if (lr < u.nvalid) {
                    const float s = (sw ? sw[u.arow + lr] : 1.0f) * (F8 ? ACT8_SCALE : 1.0f);
                    const f32x4 g0 = acc[ai][0][m][0], g1 = acc[ai][0][m][1], u0 = acc[ai][1][m][0], u1 = acc[ai][1][m][1];
                    float a[8];
#pragma unroll
                    for (int j = 0; j < 4; ++j) { a[j] = silu_f(g0[j]) * u0[j] * s; a[4 + j] = silu_f(g1[j]) * u1[j] * s; }
                    if (F8) { u32x2 w; w.x = pk4_fp8_sat(a[0], a[1], a[2], a[3]); w.y = pk4_fp8_sat(a[4], a[5], a[6], a[7]);
                        *(GAS u32x2*)((GAS unsigned char*)O + (size_t)(u.arow + lr) * DFF + col0) = w; }
                    else { u32x4 w; w.x = pk2(a[0], a[1]); w.y = pk2(a[2], a[3]); w.z = pk2(a[4], a[5]); w.w = pk2(a[6], a[7]);
                        *(GAS u32x4*)(O + (size_t)(u.arow + lr) * DFF + col0) = w; } }
                asm volatile("" ::: "memory"); }
    }
};
struct EpiDown {
    static constexpr bool PERM = false;
    gf32* out; gbf* Y;
    __device__ __forceinline__ void operator()(const f32x4 (&acc)[2][2][4][2], const Unit& u, int wr, int wc, int fr, int fq) const {
        const int lr0 = wr * 64 + fr, col0 = u.pn * BM + wc * 32 + 4 * fq;
#pragma unroll
        for (int ai = 0; ai < 2; ++ai)
#pragma unroll
            for (int m = 0; m < 4; ++m) { const int lr = lr0 + ai * HALF + m * 16;
                if (lr < u.nvalid) {
                    if (Y) { gbf* rowp = Y + (size_t)(u.arow + lr) * D + col0;
#pragma unroll
                        for (int bj = 0; bj < 2; ++bj)
#pragma unroll
                            for (int n = 0; n < 2; ++n) { const f32x4 v = acc[ai][bj][m][n]; u32x2 o; o.x = pk2(v[0], v[1]); o.y = pk2(v[2], v[3]); *(GAS u32x2*)(rowp + bj * HALF + n * 16) = o; }
                    } else { gf32* rowp = out + (size_t)(u.arow + lr) * D + col0;
#pragma unroll
                        for (int bj = 0; bj < 2; ++bj)
#pragma unroll
                            for (int n = 0; n < 2; ++n) { const f32x4 r = *(const GAS f32x4*)(rowp + bj * HALF + n * 16); *(GAS f32x4*)(rowp + bj * HALF + n * 16) = r + acc[ai][bj][m][n]; }
                    } }
                asm volatile("" ::: "memory"); }
    }
};

template <class Epi, class Sched, bool FP8 = false, bool ALIGN_EPI = true>
__device__ __forceinline__ void gemm_phase(LAS unsigned char* lds, const Gemm g, const Sched& S, const Epi& E, const int tid) {
    const int wid = __builtin_amdgcn_readfirstlane(tid >> 6), lane = tid & 63, wr = wid >> 2, wc = wid & 3, fr = lane & 15, fq = lane >> 4;
    const int K = g.K, rowb = FP8 ? K : 2 * K, nt = rowb / 128;
    unsigned voffA[2], voffB[2];
#pragma unroll
    for (int i = 0; i < 2; ++i) { int R, C; stage_rc(tid * 16 + i * 8192, R, C); const int Rb = Epi::PERM ? ((R & ~31) + perm32(R & 31)) : R;
        voffA[i] = (unsigned)(R * rowb + C * 2); voffB[i] = (unsigned)(Rb * rowb + C * 2); }
    const size_t kstep = (size_t)(BK * 2);
    const size_t hstep = (size_t)HALF * rowb;
    const size_t rstep = (size_t)rowb;
    const unsigned ldsw = (unsigned)wid * 1024u;
    const int aoff = lds_byte(wr * 64 + fr, fq * 8), boff = lds_byte(wc * 32 + fr, fq * 8);
    const int cL = (fq >> 1) * 32 + (2 * (fq & 1)) * 8, cH = cL + 8;
    const int aoffL = lds_byte(wr * 64 + fr, cL), aoffH = lds_byte(wr * 64 + fr, cH), boffL = lds_byte(wc * 32 + fr, cL), boffH = lds_byte(wc * 32 + fr, cH);
#define PG8_SA(b, h) (((b) * 2 + (h)) * HTB)
#define PG8_SB(b, h) ((4 + (b) * 2 + (h)) * HTB)
#define PG8_STAGE(bufoff, gbase, voff) do { _Pragma("unroll") for (int _i = 0; _i < 2; ++_i) \
        __builtin_amdgcn_global_load_lds((const unsigned*)((const char*)(gbase) + (voff)[_i]), (LAS unsigned*)(lds + (bufoff) + ldsw + _i * 8192), 16, 0, 0); } while (0)
#define PG8_LD2(p0, p1) ({ const v4i32 l_ = *(const LAS v4i32*)(p0), h_ = *(const LAS v4i32*)(p1); __builtin_shufflevector(l_, h_, 0, 1, 2, 3, 4, 5, 6, 7); })
#define PG8_LDA(dst, b, h) do { _Pragma("unroll") for (int m = 0; m < 4; ++m) dst[m] = FP8 ? PG8_LD2(lds + PG8_SA(b, h) + aoffL + m * 2048, lds + PG8_SA(b, h) + aoffH + m * 2048) \
        : PG8_LD2(lds + PG8_SA(b, h) + aoff + m * 2048, lds + PG8_SA(b, h) + aoff + m * 2048 + 1024); } while (0)
#define PG8_LDB(dst, b, h) do { _Pragma("unroll") for (int n = 0; n < 2; ++n) dst[n] = FP8 ? PG8_LD2(lds + PG8_SB(b, h) + boffL + n * 2048, lds + PG8_SB(b, h) + boffH + n * 2048) \
        : PG8_LD2(lds + PG8_SB(b, h) + boff + n * 2048, lds + PG8_SB(b, h) + boff + n * 2048 + 1024); } while (0)
#define PG8_LO(x) __builtin_bit_cast(bf16x8, __builtin_shufflevector((x), (x), 0, 1, 2, 3))
#define PG8_HI(x) __builtin_bit_cast(bf16x8, __builtin_shufflevector((x), (x), 4, 5, 6, 7))
#define PG8_MMA(ai, bj, At, Bt) do { __builtin_amdgcn_s_setprio(1); _Pragma("unroll") for (int m = 0; m < 4; ++m) _Pragma("unroll") for (int n = 0; n < 2; ++n) { \
        if (FP8) asm volatile("v_mfma_scale_f32_16x16x128_f8f6f4 %0, %1, %2, %0, %3, %4 op_sel_hi:[0,0,0]" : "+v"(acc[ai][bj][m][n]) : "v"(Bt[n]), "v"(At[m]), "v"(scb_v), "v"(sca_v));   \
        else { acc[ai][bj][m][n] = __builtin_amdgcn_mfma_f32_16x16x32_bf16(PG8_LO(Bt[n]), PG8_LO(At[m]), acc[ai][bj][m][n], 0, 0, 0); \
               acc[ai][bj][m][n] = __builtin_amdgcn_mfma_f32_16x16x32_bf16(PG8_HI(Bt[n]), PG8_HI(At[m]), acc[ai][bj][m][n], 0, 0, 0); } } \
        __builtin_amdgcn_s_setprio(0); } while (0)
#define PG8_WAIT_V(n) asm volatile("s_waitcnt vmcnt(" #n ")" ::: "memory")
#define PG8_WAIT_L(n) asm volatile("s_waitcnt lgkmcnt(" #n ")" ::: "memory")
#define PG8_BAR __builtin_amdgcn_s_barrier()
#define PG8_SCHED __builtin_amdgcn_sched_barrier(0)
    Unit cur, nxt; int ui = 0;
    if (!S.next(0, cur)) return;
    f32x4 acc[2][2][4][2];
#pragma unroll
    for (int a = 0; a < 2; ++a)
#pragma unroll
        for (int b = 0; b < 2; ++b)
#pragma unroll
            for (int m = 0; m < 4; ++m)
#pragma unroll
                for (int n = 0; n < 2; ++n) acc[a][b][m][n] = (f32x4){0.f, 0.f, 0.f, 0.f};
    v8i32 At[4], B0[2], B1[2];
    const int sca_v = g.sca, scb_v = g.scb;
    const char* cA = (const char*)g.A + (size_t)cur.arow * rstep; const char* cB = (const char*)g.Bt + (size_t)cur.brow * rstep;
    PG8_STAGE(PG8_SB(0, 0), cB, voffB); PG8_STAGE(PG8_SB(0, 1), cB + hstep, voffB); PG8_STAGE(PG8_SA(0, 0), cA, voffA); PG8_STAGE(PG8_SA(0, 1), cA + hstep, voffA);
    if (wr == 1) PG8_BAR;
    PG8_WAIT_V(2); PG8_BAR;
    PG8_STAGE(PG8_SB(1, 0), cB + kstep, voffB); PG8_STAGE(PG8_SA(1, 0), cA + kstep, voffA); PG8_STAGE(PG8_SB(1, 1), cB + hstep + kstep, voffB);
    PG8_WAIT_V(6); PG8_BAR;
    for (;;) {
        const bool has_next = S.next(ui + 1, nxt);
        const char* nA = has_next ? (const char*)g.A + (size_t)nxt.arow * rstep : cA; const char* nB = has_next ? (const char*)g.Bt + (size_t)nxt.brow * rstep : cB;
        for (int t = 0; t < nt; t += 2) {
            const bool last = (t == nt - 2);
            const char* a1 = cA + (size_t)(t + 1) * kstep;
            const char* a2 = last ? nA : cA + (size_t)(t + 2) * kstep; const char* b2 = last ? nB : cB + (size_t)(t + 2) * kstep;
            const char* a3 = a2 + kstep; const char* b3 = b2 + kstep;
            PG8_LDB(B0, 0, 0); PG8_LDB(B1, 0, 1); PG8_SCHED; PG8_LDA(At, 0, 0); PG8_STAGE(PG8_SA(1, 1), a1 + hstep, voffA);
            PG8_WAIT_V(8); PG8_WAIT_L(0); PG8_BAR; PG8_MMA(0, 0, At, B0); PG8_MMA(0, 1, At, B1); PG8_BAR; PG8_SCHED;
            PG8_LDA(At, 0, 1); PG8_STAGE(PG8_SB(0, 0), b2, voffB); PG8_STAGE(PG8_SB(0, 1), b2 + hstep, voffB); PG8_STAGE(PG8_SA(0, 0), a2, voffA);
            PG8_WAIT_V(8); PG8_WAIT_L(0); PG8_BAR; PG8_MMA(1, 0, At, B0); PG8_MMA(1, 1, At, B1); PG8_BAR; PG8_SCHED;
            PG8_LDB(B0, 1, 0); PG8_LDB(B1, 1, 1); PG8_SCHED; PG8_LDA(At, 1, 0); PG8_STAGE(PG8_SA(0, 1), a2 + hstep, voffA);
            PG8_WAIT_V(8); PG8_WAIT_L(0); PG8_BAR; PG8_MMA(0, 0, At, B0); PG8_MMA(0, 1, At, B1); PG8_BAR; PG8_SCHED;
            PG8_LDA(At, 1, 1); PG8_STAGE(PG8_SB(1, 0), b3, voffB); PG8_STAGE(PG8_SB(1, 1), b3 + hstep, voffB); PG8_STAGE(PG8_SA(1, 0), a3, voffA);
            PG8_WAIT_V(8); PG8_WAIT_L(0); PG8_BAR; PG8_MMA(1, 0, At, B0); PG8_MMA(1, 1, At, B1); PG8_BAR; PG8_SCHED;
        }
        if constexpr (ALIGN_EPI) { if (wr == 0) PG8_BAR; }
        { int tz = tid; asm volatile("" : "+v"(tz));
            const int wid_e = __builtin_amdgcn_readfirstlane(tz >> 6), lane_e = tz & 63; E(acc, cur, wid_e >> 2, wid_e & 3, lane_e & 15, lane_e >> 4); }
        if (!has_next) break;
#pragma unroll
        for (int a = 0; a < 2; ++a)
#pragma unroll
            for (int b = 0; b < 2; ++b)
#pragma unroll
                for (int m = 0; m < 4; ++m)
#pragma unroll
                    for (int n = 0; n < 2; ++n) acc[a][b][m][n] = (f32x4){0.f, 0.f, 0.f, 0.f};
        cur = nxt; cA = nA; cB = nB; ++ui;
        if constexpr (ALIGN_EPI) { if (wr == 1) PG8_BAR; }
    }
    PG8_WAIT_V(0);
    if constexpr (!ALIGN_EPI) { if (wr == 0) PG8_BAR; }
    PG8_BAR;
#undef PG8_SA
#undef PG8_SB
#undef PG8_STAGE
#undef PG8_LDA
#undef PG8_LDB
#undef PG8_MMA
#undef PG8_LD2
#undef PG8_LO
#undef PG8_HI
#undef PG8_WAIT_V
#undef PG8_WAIT_L
#undef PG8_BAR
#undef PG8_SCHED
}
}

#define XB_TMO      128
#define XB_XCNT(j)  (256  + 64 * (j))
#define XB_XSUB(j)  (1280 + 64 * (j))
#define XB_XGEN(j)  (2304 + 64 * (j))
#define XB_TOP      3328
#define XB_TOPGEN   3392
#define XCD_BAR_WORDS 3456
#define XB_SPIN_CAP (1u << 18)
__device__ __forceinline__ unsigned xb_ld(unsigned* p)              { return __hip_atomic_load(p, __ATOMIC_RELAXED, __HIP_MEMORY_SCOPE_AGENT); }
__device__ __forceinline__ unsigned xb_add(unsigned* p, unsigned v) { return __hip_atomic_fetch_add(p, v, __ATOMIC_RELAXED, __HIP_MEMORY_SCOPE_AGENT); }
__device__ __forceinline__ unsigned xb_xcc_id() { return (unsigned)__builtin_amdgcn_s_getreg((3 << 11) | 20) & 0xFu; }
#define XB_SPIN(cond, bar) do { unsigned _sp = 0; while (cond) { __builtin_amdgcn_s_sleep(1); \
    if ((++_sp & 255u) == 0u) { if (xb_ld(&(bar)[XB_TMO])) break; if (_sp > XB_SPIN_CAP) { atomicAdd(&(bar)[XB_TMO], 1u); break; } } } } while (0)
struct XcdBarrier { unsigned* bar; unsigned x; volatile LAS unsigned* st; };
__device__ __forceinline__ XcdBarrier xcd_barrier_post(unsigned* bar, volatile LAS unsigned* st) {
    XcdBarrier b; b.bar = bar; b.x = xb_xcc_id(); b.st = st;
    if (threadIdx.x == 0) (void)xb_add(&bar[XB_XCNT(b.x)], 1u);
    return b;
}
__device__ __forceinline__ void xcd_barrier_complete(unsigned* bar, unsigned x, unsigned& nloc, unsigned& nx) {
    const unsigned G = gridDim.x * gridDim.y * gridDim.z;
    unsigned sum, cnt, mine, sp = 0u;
    for (;;) {
        sum = 0u; cnt = 0u; mine = 0u;
#pragma unroll
        for (unsigned j = 0; j < 16; ++j) { const unsigned c = xb_ld(&bar[XB_XCNT(j)]); sum += c; cnt += (c > 0u) ? 1u : 0u; mine = (j == x) ? c : mine; }
        if (sum == G) break;
        __builtin_amdgcn_s_sleep(1);
        if ((++sp & 255u) == 0u) { if (xb_ld(&bar[XB_TMO])) break; if (sp > XB_SPIN_CAP) { atomicAdd(&bar[XB_TMO], 1u); break; } }
    }
    nloc = mine > 0u ? mine : 1u; nx = cnt > 0u ? cnt : 1u;
}
__device__ __forceinline__ void xcd_barrier(const XcdBarrier& b) {
    asm volatile("s_waitcnt vmcnt(0)" ::: "memory");
    __syncthreads();
    if (threadIdx.x == 0) {
        unsigned* bar = b.bar;
        __builtin_amdgcn_s_waitcnt(0);
        unsigned nloc = b.st[0], nx = b.st[1];
        if (nloc == 0u) { xcd_barrier_complete(bar, b.x, nloc, nx); b.st[0] = nloc; b.st[1] = nx; }
        const unsigned old = xb_add(&bar[XB_XSUB(b.x)], 1u);
        const unsigned gen = old / nloc;
        if (old + 1u == (gen + 1u) * nloc) {
            __builtin_amdgcn_fence(__ATOMIC_RELEASE, "agent");
            asm volatile("s_waitcnt vmcnt(0)" ::: "memory");
            const unsigned og = xb_add(&bar[XB_TOP], 1u);
            const unsigned tg = og / nx;
            if (og + 1u == (tg + 1u) * nx) xb_add(&bar[XB_TOPGEN], 1u);
            else XB_SPIN(xb_ld(&bar[XB_TOPGEN]) == tg, bar);
            __builtin_amdgcn_fence(__ATOMIC_ACQUIRE, "agent");
            xb_add(&bar[XB_XGEN(b.x)], 1u);
            asm volatile("s_waitcnt vmcnt(0)" ::: "memory");
        } else {
            XB_SPIN(xb_ld(&bar[XB_XGEN(b.x)]) == gen, bar);
            __builtin_amdgcn_fence(__ATOMIC_ACQUIRE, "agent");
            asm volatile("s_waitcnt vmcnt(0)" ::: "memory");
        }
    }
    __syncthreads();
}

struct Args { const float* in[27]; float* out; unsigned char* ws; int ph_lo, ph_hi; };
struct Frame {
    LAS unsigned char* lds;
    volatile LAS unsigned* MISC;
    gu32* ctl;
    int tid, lane, wave, G, bx;
    GAS unsigned char* ws;
};

struct CvItem { const gf32* W; GAS unsigned char* WT; int ldw, K, k0, s0, n0; bool f8; };
__device__ __forceinline__ void tr_load(f32x4 (&v)[16], const CvItem& c, int lane) {
    const gf32* src = c.W + (size_t)(c.k0 + (lane >> 4)) * c.ldw + c.s0 + 4 * (lane & 15);
#pragma unroll
    for (int i = 0; i < 16; ++i) { v[i] = *(const GAS f32x4*)src; src += 4 * c.ldw; }
}
__device__ __forceinline__ void tr_store(const f32x4 (&v)[16], const CvItem& cv, LAS float* scr, int lane) {
    const int l16 = lane & 15, lq = lane >> 4, c = lane & 7;
    LAS float* p = scr + lq * 65 + 4 * l16;
#pragma unroll
    for (int i = 0; i < 16; ++i) { p[i * 260 + 0] = v[i][0]; p[i * 260 + 1] = v[i][1]; p[i * 260 + 2] = v[i][2]; p[i * 260 + 3] = v[i][3]; }
    LDS_WAIT(); asm volatile("" ::: "memory");
    const LAS float* s = scr + (8 * c) * 65 + (lane >> 3);
    if (cv.f8) {
        GAS unsigned char* dst = cv.WT + (size_t)(cv.n0 + (lane >> 3)) * cv.K + cv.k0 + 8 * c;
#pragma unroll
        for (int j = 0; j < 8; ++j) {
            u32x2 o; o.x = pk4_fp8(s[8 * j + 0 * 65] * W8_SCALE, s[8 * j + 1 * 65] * W8_SCALE, s[8 * j + 2 * 65] * W8_SCALE, s[8 * j + 3 * 65] * W8_SCALE);
            o.y = pk4_fp8(s[8 * j + 4 * 65] * W8_SCALE, s[8 * j + 5 * 65] * W8_SCALE, s[8 * j + 6 * 65] * W8_SCALE, s[8 * j + 7 * 65] * W8_SCALE);
            *(GAS u32x2*)dst = o; dst += (size_t)8 * cv.K; }
    } else {
        GAS unsigned char* dst = cv.WT + ((size_t)(cv.n0 + (lane >> 3)) * cv.K + cv.k0 + 8 * c) * 2;
#pragma unroll
        for (int j = 0; j < 8; ++j) {
            u32x4 o; o.x = pk2(s[8 * j + 0 * 65], s[8 * j + 1 * 65]); o.y = pk2(s[8 * j + 2 * 65], s[8 * j + 3 * 65]); o.z = pk2(s[8 * j + 4 * 65], s[8 * j + 5 * 65]); o.w = pk2(s[8 * j + 6 * 65], s[8 * j + 7 * 65]);
            *(GAS u32x4*)dst = o; dst += (size_t)16 * cv.K; }
    }
    LDS_WAIT(); asm volatile("" ::: "memory");
}
constexpr int I_IN = 32 * 104, I_OUT = 32 * 32, I_GU = 32 * 176, I_DN = 88 * 32;
constexpr int I_EXP = I_GU + I_DN, NITEMS = 2 * I_IN + 2 * I_OUT + (1 + NE) * I_EXP;
struct CvSrc { const gf32 *w_in, *w_out, *fg, *fu, *fd, *mg, *mu, *md; };
__device__ __forceinline__ CvItem cv_decode(Frame& F, int pair, int half, const CvSrc& a) {
    int r = pair; CvItem c; c.f8 = false;
    if (r < 2 * I_IN) { const int l = r / I_IN; r -= l * I_IN; const int q = r >> 1, kb = 2 * (q / 104), nb = q % 104; c.n0 = 64 * nb; c.k0 = 64 * kb;
        c.W = a.w_in + (size_t)l * D * DIN; c.ldw = DIN; c.s0 = c.n0 < 4608 ? c.n0 : c.n0 + 12; c.WT = F.ws + WS_WIN + (size_t)l * SZ_WIN; c.K = D; }
    else if (r < 2 * I_IN + 2 * I_OUT) { r -= 2 * I_IN; const int l = r / I_OUT; r -= l * I_OUT; const int q = r >> 1, kb = 2 * (q / 32), nb = q % 32; c.n0 = 64 * nb; c.k0 = 64 * kb;
        c.W = a.w_out + (size_t)l * D * D; c.ldw = D; c.s0 = c.n0; c.WT = F.ws + WS_WOUT + (size_t)l * SZ_WOUT; c.K = D; }
    else { r -= 2 * I_IN + 2 * I_OUT;
        const int grp = r / I_EXP; r -= grp * I_EXP; const int e = grp - 1; c.f8 = (grp != 0) || (DENSE_GU_F8 && r < I_GU) || (DENSE_DN_F8 && r >= I_GU);
        if (r < I_GU) { const int q = r >> 1, kb = 2 * (q / 176), nb = q % 176; c.n0 = 64 * nb; c.k0 = 64 * kb; const int pn = c.n0 >> 8, r0 = c.n0 & 255;
            const gf32* Wg = grp == 0 ? a.fg : a.mg + (size_t)e * D * DFF; const gf32* Wu = grp == 0 ? a.fu : a.mu + (size_t)e * D * DFF;
            c.W = r0 < 128 ? Wg : Wu; c.ldw = DFF; c.s0 = 128 * pn + (r0 & 127); c.WT = grp == 0 ? (F.ws + WS_WGU) : (F.ws + WS_MGU) + (size_t)e * 2 * DFF * D; c.K = D; }
        else { r -= I_GU; const int q = r >> 1, kb = 2 * (q / 32), nb = q % 32; c.n0 = 64 * nb; c.k0 = 64 * kb;
            c.W = grp == 0 ? a.fd : a.md + (size_t)e * DFF * D; c.ldw = D; c.s0 = c.n0; c.WT = grp == 0 ? (F.ws + WS_WDN) : (F.ws + WS_MDN) + (size_t)e * D * DFF; c.K = DFF; } }
    c.k0 += 64 * half;
    return c;
}
template <class Map> __device__ __forceinline__ void cv_run(Frame& F, int first, int stride, int n, Map map, const CvSrc& a, LAS float* scr) {
    if (n <= 0) return;
    f32x4 va[16], vb[16];
    CvItem ca = cv_decode(F, map(first), 0, a), cb; tr_load(va, ca, F.lane);
#pragma unroll 1
    for (int j = 0; j < n; ++j) {
        cb = cv_decode(F, map(first + j * stride), 1, a); tr_load(vb, cb, F.lane);
        tr_store(va, ca, scr, F.lane);
        if (j + 1 < n) { ca = cv_decode(F, map(first + (j + 1) * stride), 0, a); tr_load(va, ca, F.lane); }
        tr_store(vb, cb, scr, F.lane);
    }
}
constexpr int N_IMM = I_IN + I_OUT + I_EXP, N_DEF = NITEMS - N_IMM, N_DEF_UNITS = N_DEF / 64;
static_assert(N_DEF % 64 == 0, "deferred conversion units");
__device__ __forceinline__ int imm_item(int i) { return i < I_IN ? i : (i < I_IN + I_OUT ? 2 * I_IN + (i - I_IN) : 2 * I_IN + 2 * I_OUT + (i - I_IN - I_OUT)); }
__device__ __forceinline__ int def_item(int d) { return d < I_IN ? I_IN + d : (d < I_IN + I_OUT ? 2 * I_IN + I_OUT + (d - I_IN) : 2 * I_IN + 2 * I_OUT + I_EXP + (d - I_IN - I_OUT)); }
__device__ __forceinline__ void p0_prologue(Frame& F, const Args& a) {
    LAS float* scr = (LAS float*)(F.lds) + F.wave * (64 * 65);
    const int gw = F.bx * NWAVES + F.wave, NGW = F.G * NWAVES;
    gbf* Win = (gbf*)(F.ws + WS_WIN);
    { const CvSrc src{(const gf32*)a.in[3], (const gf32*)a.in[18], (const gf32*)a.in[20], (const gf32*)a.in[21], (const gf32*)a.in[22], (const gf32*)a.in[24], (const gf32*)a.in[25], (const gf32*)a.in[26]};
        const int npairs = N_IMM / 2, mine = gw < npairs ? (npairs - gw + NGW - 1) / NGW : 0;
        cv_run(F, 2 * gw, 2 * NGW, mine, [](int i) { return imm_item(i); }, src, scr); }
    for (int i = F.bx * NTHR + F.tid; i < 2 * 256 * (D / 8); i += F.G * NTHR) {
        const int l = i / (256 * (D / 8)), rr = i % (256 * (D / 8)), n = rr / (D / 8), k8 = rr % (D / 8);
        const int src = n < 12 ? 4608 + n : (n < 24 ? 6668 + (n - 12) : -1);
        u32x4 o = {0u, 0u, 0u, 0u};
        if (src >= 0) { const gf32* w = (const gf32*)a.in[3] + (size_t)l * D * DIN + (size_t)(8 * k8) * DIN + src;
            o.x = pk2(w[0], w[DIN]); o.y = pk2(w[2 * DIN], w[3 * DIN]); o.z = pk2(w[4 * DIN], w[5 * DIN]); o.w = pk2(w[6 * DIN], w[7 * DIN]); }
        *(GAS u32x4*)(Win + (size_t)l * NPJ * D + (size_t)(PC_SMALL + n) * D + 8 * k8) = o;
    }
}

template <bool ROUTER, bool F8OUT>
__device__ __forceinline__ void norm_phase(Frame& F, const gf32* x, const gf32* gain, gbf* Hout, const gf32* router) {
    const int tpw = (M + F.G - 1) / F.G, m0 = F.bx * tpw, m1 = (m0 + tpw < M) ? m0 + tpw : M;
    LAS float* RT = (LAS float*)F.lds;
    LAS int* hist = (LAS int*)(F.lds + 65536);
    if (ROUTER) {
        for (int i = F.tid; i < D * NE; i += NTHR) RT[(i & 7) * D + (i >> 3)] = router[i];
        if (F.tid < 8) hist[F.tid] = 0;
        __syncthreads();
    }
    gi32* toke = (gi32*)(F.ws + WS_ROUTE + RT_TOKE); gf32* tokw = (gf32*)(F.ws + WS_ROUTE + RT_TOKW);
    for (int m = m0 + F.wave; m < m1; m += NWAVES) {
        const GAS f32x4* xr = (const GAS f32x4*)(x + (size_t)m * D) + F.lane;
        f32x4 v[8]; float s = 0.f;
#pragma unroll
        for (int j = 0; j < 8; ++j) { v[j] = xr[64 * j]; s += (v[j].x * v[j].x + v[j].y * v[j].y) + (v[j].z * v[j].z + v[j].w * v[j].w); }
        const float rstd = 1.0f / sqrtf(wave_sum(s, F.lane) * (1.0f / D) + NORM_EPS);
        GAS u32x2* o8 = (GAS u32x2*)(Hout + (size_t)m * D) + F.lane; GAS unsigned* o4 = (GAS unsigned*)((GAS unsigned char*)Hout + (size_t)m * D) + F.lane;
#pragma unroll
        for (int j = 0; j < 8; ++j) { const f32x4 g = ((const GAS f32x4*)gain)[F.lane + 64 * j]; v[j] = v[j] * rstd * g;
            if (F8OUT) o4[64 * j] = pk4_fp8_sat(v[j].x, v[j].y, v[j].z, v[j].w);
            else { u32x2 w; w.x = pk2(v[j].x, v[j].y); w.y = pk2(v[j].z, v[j].w); o8[64 * j] = w; } }
        if (ROUTER) {
            float lg[8];
#pragma unroll
            for (int e = 0; e < 8; ++e) { float acc = 0.f;
#pragma unroll
                for (int j = 0; j < 8; ++j) { const f32x4 r = *(const LAS f32x4*)(RT + e * D + 4 * F.lane + 256 * j); acc += (v[j].x * r.x + v[j].y * r.y) + (v[j].z * r.z + v[j].w * r.w); }
                lg[e] = wave_sum(acc, F.lane); }
            int e1 = 0; float v1 = lg[0];
#pragma unroll
            for (int e = 1; e < 8; ++e) if (lg[e] > v1) { v1 = lg[e]; e1 = e; }
            int e2 = -1; float v2 = -3.0e38f;
#pragma unroll
            for (int e = 0; e < 8; ++e) if (e != e1 && lg[e] > v2) { v2 = lg[e]; e2 = e; }
            const float t = __expf(v2 - v1), w1 = 1.0f / (1.0f + t), w2 = t * w1;
            if (F.lane == 0) { toke[m] = e1 | (e2 << 8); tokw[2 * m] = w1; tokw[2 * m + 1] = w2; __hip_atomic_fetch_add(&hist[e1], 1, __ATOMIC_RELAXED, __HIP_MEMORY_SCOPE_WORKGROUP); __hip_atomic_fetch_add(&hist[e2], 1, __ATOMIC_RELAXED, __HIP_MEMORY_SCOPE_WORKGROUP); }
        }
    }
    if (ROUTER) {
        __syncthreads();
        if (F.tid < 8) ((gi32*)(F.ws + WS_ROUTE + RT_WGCNT))[F.bx * 8 + F.tid] = hist[F.tid];
    }
}

__device__ __forceinline__ void route_phase(Frame& F) {
    const int tpw = (M + F.G - 1) / F.G, m0 = F.bx * tpw, m1 = (m0 + tpw < M) ? m0 + tpw : M, nt = (m1 > m0) ? (m1 - m0) : 0;
    LAS int* tot = (LAS int*)F.lds;
    LAS int* pre = tot + 8;
    LAS int* base = tot + 16;
    LAS int* offs = tot + 24;
    LAS int* aexp = tot + 64;
    LAS int* apos = aexp + 2 * 128;
    const gi32* wgcnt = (const gi32*)(F.ws + WS_ROUTE + RT_WGCNT);
    const gi32* toke = (const gi32*)(F.ws + WS_ROUTE + RT_TOKE); const gf32* tokw = (const gf32*)(F.ws + WS_ROUTE + RT_TOKW);
    gi32* stok = (gi32*)(F.ws + WS_ROUTE + RT_STOK); gi32* tpos = (gi32*)(F.ws + WS_ROUTE + RT_TPOS); gf32* sw = (gf32*)(F.ws + WS_ROUTE + RT_SW); gi32* tab = (gi32*)(F.ws + WS_ROUTE + RT_TAB);
    if (F.tid < 16) tot[F.tid] = 0;
    __syncthreads();
    for (int i = F.tid; i < F.G * 8; i += NTHR) { const int v = wgcnt[i]; __hip_atomic_fetch_add(&tot[i & 7], v, __ATOMIC_RELAXED, __HIP_MEMORY_SCOPE_WORKGROUP); if ((i >> 3) < F.bx) __hip_atomic_fetch_add(&pre[i & 7], v, __ATOMIC_RELAXED, __HIP_MEMORY_SCOPE_WORKGROUP); }
    __syncthreads();
    if (F.tid == 0) { int o = 0; for (int e = 0; e < 8; ++e) { offs[e] = o; base[e] = o + pre[e]; o += tot[e]; } offs[8] = o; }
    for (int a = F.tid; a < 2 * nt; a += NTHR) { const int te = toke[m0 + (a >> 1)]; aexp[a] = (a & 1) ? (te >> 8) : (te & 0xff); }
    __syncthreads();
    for (int a = F.tid; a < 2 * nt; a += NTHR) { const int ea = aexp[a]; int rank = 0; for (int b = 0; b < a; ++b) rank += (aexp[b] == ea) ? 1 : 0;
        const int p = base[ea] + rank; apos[a] = p; stok[p] = m0 + (a >> 1); sw[p] = tokw[2 * (m0 + (a >> 1)) + (a & 1)]; tpos[2 * m0 + a] = p; }
    __syncthreads();
    const gbf* H = (const gbf*)(F.ws + WS_H); gbf* HG = (gbf*)(F.ws + WS_HG);
#pragma unroll 1
    for (int i0 = F.tid; i0 < 2 * nt * 128; i0 += 8 * NTHR) { u32x4 r[8];
#pragma unroll
        for (int u = 0; u < 8; ++u) { const int i = i0 + u * NTHR; const int ii = i < 2 * nt * 128 ? i : 0; r[u] = *(const GAS u32x4*)((const GAS unsigned char*)H + (size_t)(m0 + (ii >> 8)) * D + 16 * (ii & 127)); }
#pragma unroll
        for (int u = 0; u < 8; ++u) { const int i = i0 + u * NTHR; if (i < 2 * nt * 128) *(GAS u32x4*)((GAS unsigned char*)HG + (size_t)apos[i >> 7] * D + 16 * (i & 127)) = r[u]; } }
    if (F.bx == 0 && F.tid == 0) { int T = 0;
        for (int e = 0; e < 8; ++e) { const int cnt = tot[e]; for (int r = 0; r < cnt; r += 256) { tab[4 + 4 * T] = e; tab[5 + 4 * T] = offs[e] + r; tab[6 + 4 * T] = (cnt - r < 256) ? cnt - r : 256; tab[7 + 4 * T] = 0; ++T; } }
        tab[0] = T; }
    __syncthreads();
}

constexpr size_t SCR_QN = 0, SCR_KN = 16 * MiB, SCR_VT = 32 * MiB;
constexpr size_t SCR_GW = 48 * MiB, SCR_GQD = 72 * MiB, SCR_GKDT = 96 * MiB, SCR_GUT = 120 * MiB, SCR_GQK = 144 * MiB, SCR_GDEC = 156 * MiB;
constexpr size_t SCR_ST = 157 * MiB, SCR_PREV = 205 * MiB, SCR_CDEC = 229 * MiB, SCR_END = 230 * MiB;
static_assert(WS_SCR + SCR_END <= WS_BIG + (size_t)600 * MiB, "scratch");
constexpr float LOG2E = 1.4426950408889634f;
constexpr size_t WS_NEED = (WS_SCR + SCR_END > WS_END_MOE) ? WS_SCR + SCR_END : WS_END_MOE;

__device__ __forceinline__ bf16x8 ld_frag16(const LAS unsigned char* p) { return *(const LAS bf16x8*)p; }
__device__ __forceinline__ bf16x8 ld_frag8x2(const LAS unsigned char* p0, const LAS unsigned char* p1) {
    const s16x4 a = *(const LAS s16x4*)p0, b = *(const LAS s16x4*)p1; return (bf16x8){a[0], a[1], a[2], a[3], b[0], b[1], b[2], b[3]}; }
__device__ __forceinline__ bf16x8 pack_frag(const f32x4 a, const f32x4 b) {
    u32x4 w; w.x = pk2(a[0], a[1]); w.y = pk2(a[2], a[3]); w.z = pk2(b[0], b[1]); w.w = pk2(b[2], b[3]); return __builtin_bit_cast(bf16x8, w); }
#define MFMA16(a, b, c) __builtin_amdgcn_mfma_f32_16x16x32_bf16((a), (b), (c), 0, 0, 0)

__device__ __forceinline__ void attn_prep_unit(Frame& F, int u, const gf32* qgain, const gf32* kgain) {
    const gbf* PROJ = (const gbf*)(F.ws + WS_PROJ);
    gbf* QN = (gbf*)(F.ws + WS_SCR + SCR_QN); gbf* KN = (gbf*)(F.ws + WS_SCR + SCR_KN); gbf* VT = (gbf*)(F.ws + WS_SCR + SCR_VT);
    const int m0 = 64 * u, b = m0 >> 12, t0 = m0 & 4095;
    for (int task = F.tid; task < 1024; task += NTHR) {
        const int tok = task >> 4, grp = task & 15, isk = grp >> 3, g8 = grp & 7;
        const gbf* src = PROJ + (size_t)(m0 + tok) * NPJ + (isk ? PC_AK : PC_AQ) + g8 * 64;
        u32x4 w[8]; float ss = 0.f;
#pragma unroll
        for (int i = 0; i < 8; ++i) { w[i] = *(const GAS u32x4*)(src + 8 * i);
#pragma unroll
            for (int k = 0; k < 4; ++k) { const float a = bflo(w[i][k]), c = bfhi(w[i][k]); ss += a * a + c * c; } }
        const float r = (1.0f / sqrtf(ss * (1.0f / 64.f) + NORM_EPS)) * (isk ? 1.0f : 0.125f * LOG2E);
        const gf32* gn = isk ? kgain : qgain; gbf* dst = (isk ? KN : QN) + (size_t)(m0 + tok) * 512 + g8 * 64;
#pragma unroll
        for (int i = 0; i < 8; ++i) { const f32x4 g0 = *(const GAS f32x4*)(gn + 8 * i), g1 = *(const GAS f32x4*)(gn + 8 * i + 4); u32x4 o;
            o.x = pk2(bflo(w[i].x) * r * g0.x, bfhi(w[i].x) * r * g0.y); o.y = pk2(bflo(w[i].y) * r * g0.z, bfhi(w[i].y) * r * g0.w);
            o.z = pk2(bflo(w[i].z) * r * g1.x, bfhi(w[i].z) * r * g1.y); o.w = pk2(bflo(w[i].w) * r * g1.z, bfhi(w[i].w) * r * g1.w);
            *(GAS u32x4*)(dst + 8 * i) = o; }
    }
    LAS unsigned char* Vs = F.lds;
    for (int idx = F.tid; idx < 4096; idx += NTHR) { const int tok = idx >> 6, c16 = idx & 63;
        *(LAS u32x4*)(Vs + tok * 1040 + c16 * 16) = *(const GAS u32x4*)(PROJ + (size_t)(m0 + tok) * NPJ + PC_AV + 8 * c16); }
    __syncthreads();
    for (int idx = F.tid; idx < 4096; idx += NTHR) { const int row = idx >> 3, ch = idx & 7;
        unsigned short e[8];
#pragma unroll
        for (int j = 0; j < 8; ++j) e[j] = *(const LAS unsigned short*)(Vs + (8 * ch + j) * 1040 + 2 * row);
        u32x4 o; o.x = e[0] | ((unsigned)e[1] << 16); o.y = e[2] | ((unsigned)e[3] << 16); o.z = e[4] | ((unsigned)e[5] << 16); o.w = e[6] | ((unsigned)e[7] << 16);
        *(GAS u32x4*)(VT + ((size_t)(b * 4 + (row >> 7)) * 128 + (row & 127)) * SEQ + t0 + 8 * ch) = o; }
    __syncthreads();
}

template <bool ROWMAJOR, class Sc, class St>
__device__ __forceinline__ void conv8x16(const gbf* src, bool has_halo, const gf32* w, int NC, const gf32* bias, Sc scale, St store) {
    u32x4 x[19];
#pragma unroll
    for (int i = 0; i < 3; ++i) x[i] = has_halo ? *(const GAS u32x4*)(src + (i - 3) * NPJ) : (u32x4){0u, 0u, 0u, 0u};
#pragma unroll
    for (int i = 3; i < 19; ++i) x[i] = *(const GAS u32x4*)(src + (i - 3) * NPJ);
    float wt[4][8], bs[8];
#pragma unroll
    for (int j = 0; j < 4; ++j) { const f32x4 a = *(const GAS f32x4*)(w + j * NC), c = *(const GAS f32x4*)(w + j * NC + 4);
        wt[j][0] = a.x; wt[j][1] = a.y; wt[j][2] = a.z; wt[j][3] = a.w; wt[j][4] = c.x; wt[j][5] = c.y; wt[j][6] = c.z; wt[j][7] = c.w; }
    if (bias) { const f32x4 a = *(const GAS f32x4*)bias, c = *(const GAS f32x4*)(bias + 4); bs[0] = a.x; bs[1] = a.y; bs[2] = a.z; bs[3] = a.w; bs[4] = c.x; bs[5] = c.y; bs[6] = c.z; bs[7] = c.w; }
    else {
#pragma unroll
        for (int k = 0; k < 8; ++k) bs[k] = 0.f; }
#define CX(i, k) (((k) & 1) ? bfhi(x[i][(k) >> 1]) : bflo(x[i][(k) >> 1]))
    if (ROWMAJOR) {
#pragma unroll
        for (int i = 0; i < 16; ++i) { const float sc = scale(i); float v[8];
#pragma unroll
            for (int k = 0; k < 8; ++k) v[k] = silu_f(wt[0][k] * CX(i, k) + wt[1][k] * CX(i + 1, k) + wt[2][k] * CX(i + 2, k) + wt[3][k] * CX(i + 3, k) + bs[k]) * sc;
            store(i, (u32x4){pk2(v[0], v[1]), pk2(v[2], v[3]), pk2(v[4], v[5]), pk2(v[6], v[7])}, (u32x4){0u, 0u, 0u, 0u}); }
    } else {
#pragma unroll
        for (int k = 0; k < 8; ++k) { float v[16];
#pragma unroll
            for (int i = 0; i < 16; ++i) v[i] = silu_f(wt[0][k] * CX(i, k) + wt[1][k] * CX(i + 1, k) + wt[2][k] * CX(i + 2, k) + wt[3][k] * CX(i + 3, k) + bs[k]) * scale(i);
            store(k, (u32x4){pk2(v[0], v[1]), pk2(v[2], v[3]), pk2(v[4], v[5]), pk2(v[6], v[7])}, (u32x4){pk2(v[8], v[9]), pk2(v[10], v[11]), pk2(v[12], v[13]), pk2(v[14], v[15])}); }
    }
#undef CX
}

__device__ __forceinline__ void gdn_prep_unit(Frame& F, int up, const gf32* convw, const gf32* A_log, const gf32* dt_bias) {
    const gbf* PROJ = (const gbf*)(F.ws + WS_PROJ); const gf32* SMALL = (const gf32*)(F.ws + WS_SMALL);
    const int bh = up >> 5, np = up & 31, b = bh / 6, h = bh % 6, t0 = 128 * np;
    LAS unsigned char* L = F.lds;
    LAS unsigned char* Qb = L; LAS unsigned char* Kb = L + 34816; LAS unsigned char* Vb = L + 69632;
    LAS float* Am = (LAS float*)(L + 104448);
    LAS float* gcs = (LAS float*)(L + 137216); LAS float* betas = gcs + 128; LAS float* rqs = gcs + 256; LAS float* rks = gcs + 384;
    if (F.tid < 384) { const int ch = F.tid / 192, rem = F.tid % 192, oct = rem >> 2, seg = rem & 3, part = oct >> 4, d0 = (oct & 15) * 8;
        const int cidx = part * 768 + h * 128 + d0, tr = t0 + 64 * ch + 16 * seg;
        LAS unsigned char* dst = (part == 0 ? Qb : (part == 1 ? Kb : Vb)) + ch * 17408 + (16 * seg) * 272 + d0 * 2;
        conv8x16<true>(PROJ + (size_t)(b * SEQ + tr) * NPJ + PC_GQKV + cidx, tr > 0, convw + cidx, 2304, (const gf32*)nullptr, [](int) { return 1.0f; },
                       [&](int i, u32x4 a, u32x4) { *(LAS u32x4*)(dst + i * 272) = a; });
    }
    if ((F.tid & 255) < 64) { const int ch = F.tid >> 8, c = F.tid & 63; const size_t m = (size_t)(b * SEQ + t0 + 64 * ch + c);
        const float beta = sigmoid_f(SMALL[m * 32 + h]);
        const float g = -__expf(A_log[h]) * softplus_f(SMALL[m * 32 + 6 + h] + dt_bias[h]);
        float s = g;
#pragma unroll
        for (int o = 1; o < 64; o <<= 1) { const float t = __builtin_bit_cast(float, __builtin_amdgcn_ds_bpermute(((F.lane - o) & 63) << 2, __builtin_bit_cast(int, s))); if (c >= o) s += t; }
        gcs[ch * 64 + c] = s; betas[ch * 64 + c] = beta; }
    __syncthreads();
    { const int ch = F.tid >> 8, isk = (F.tid >> 7) & 1, c = (F.tid >> 1) & 63, part = F.tid & 1;
        const LAS unsigned char* row = (isk ? Kb : Qb) + ch * 17408 + c * 272 + part * 128; float ss = 0.f;
#pragma unroll
        for (int i = 0; i < 8; ++i) { const u32x4 w = *(const LAS u32x4*)(row + 16 * i);
#pragma unroll
            for (int k = 0; k < 4; ++k) { const float a = bflo(w[k]), e = bfhi(w[k]); ss += a * a + e * e; } }
        ss += shfl_xor_l(ss, 1, F.lane);
        if (part == 0) (isk ? rks : rqs)[ch * 64 + c] = 1.0f / sqrtf(ss + NORM_EPS); }
    __syncthreads();
    { const int ch = F.wave >> 2, ct = F.wave & 3, fr = F.lane & 15, fq = F.lane >> 4;
        const size_t cu = (size_t)bh * 64 + 2 * np + ch;
        gbf* QKc = (gbf*)(F.ws + WS_SCR + SCR_GQK) + cu * 4096;
        const LAS unsigned char* Kc = Kb + ch * 17408; const LAS unsigned char* Qc = Qb + ch * 17408;
        bf16x8 ka[4], qa[4];
#pragma unroll
        for (int kb = 0; kb < 4; ++kb) { ka[kb] = ld_frag16(Kc + (16 * ct + fr) * 272 + (32 * kb + 8 * fq) * 2); qa[kb] = ld_frag16(Qc + (16 * ct + fr) * 272 + (32 * kb + 8 * fq) * 2); }
#pragma unroll
        for (int st = 0; st < 4; ++st) {
            f32x4 akk = {0.f, 0.f, 0.f, 0.f}, aqk = {0.f, 0.f, 0.f, 0.f};
            if (st <= ct) {
#pragma unroll
                for (int kb = 0; kb < 4; ++kb) { const bf16x8 kbf = ld_frag16(Kc + (16 * st + fr) * 272 + (32 * kb + 8 * fq) * 2); akk = MFMA16(ka[kb], kbf, akk); aqk = MFMA16(qa[kb], kbf, aqk); }
            }
            const int s = 16 * st + fr; const float gs = gcs[ch * 64 + s], rks_s = rks[ch * 64 + s];
#pragma unroll
            for (int j = 0; j < 4; ++j) { const int c = 16 * ct + 4 * fq + j; const float gcv = gcs[ch * 64 + c]; const float dec = __expf(gcv - gs);
                const float av = (c > s) ? betas[ch * 64 + c] * rks[ch * 64 + c] * rks_s * akk[j] * dec : 0.f;
                const float qv = (c >= s) ? rqs[ch * 64 + c] * rks_s * 0.08838834764831845f * aqk[j] * dec : 0.f;
                Am[ch * 4096 + c * 64 + s] = av; QKc[c * 64 + s] = f2bf(qv); }
        }
    }
    __syncthreads();
    { const int ch = F.tid >> 8, col = F.tid & 255; const size_t cu = (size_t)bh * 64 + 2 * np + ch;
        float x[64];
        if (col < 128) {
#pragma unroll
            for (int c = 0; c < 64; ++c) x[c] = bf2f(*(const LAS unsigned short*)(Vb + ch * 17408 + c * 272 + 2 * col)) * betas[ch * 64 + c];
        } else {
#pragma unroll
            for (int c = 0; c < 64; ++c) x[c] = bf2f(*(const LAS unsigned short*)(Kb + ch * 17408 + c * 272 + 2 * (col - 128))) * rks[ch * 64 + c] * betas[ch * 64 + c] * __expf(gcs[ch * 64 + c]);
        }
        const LAS f32x4* A4 = (const LAS f32x4*)(Am + ch * 4096);
#pragma unroll
        for (int c = 1; c < 64; ++c) { float a0 = 0.f, a1 = 0.f, a2 = 0.f, a3 = 0.f;
#pragma unroll
            for (int s4 = 0; s4 < (c + 3) / 4; ++s4) { const f32x4 a = A4[c * 16 + s4];
                a0 += a.x * x[4 * s4]; if (4 * s4 + 1 < c) a1 += a.y * x[4 * s4 + 1]; if (4 * s4 + 2 < c) a2 += a.z * x[4 * s4 + 2]; if (4 * s4 + 3 < c) a3 += a.w * x[4 * s4 + 3]; }
            x[c] -= (a0 + a1) + (a2 + a3); }
        if (col < 128) { gbf* UT = (gbf*)(F.ws + WS_SCR + SCR_GUT) + cu * 8192 + col * 64;
#pragma unroll
            for (int i = 0; i < 8; ++i) { u32x4 o; o.x = pk2(x[8 * i], x[8 * i + 1]); o.y = pk2(x[8 * i + 2], x[8 * i + 3]); o.z = pk2(x[8 * i + 4], x[8 * i + 5]); o.w = pk2(x[8 * i + 6], x[8 * i + 7]); *(GAS u32x4*)(UT + 8 * i) = o; }
        } else { gbf* Wc = (gbf*)(F.ws + WS_SCR + SCR_GW) + cu * 8192 + (col - 128);
#pragma unroll
            for (int c = 0; c < 64; ++c) Wc[c * 128] = f2bf(x[c]); }
    }
    for (int task = F.tid; task < 2048; task += NTHR) { const int ch = task >> 10, c = (task >> 4) & 63, p = task & 15; const size_t cu = (size_t)bh * 64 + 2 * np + ch;
        const u32x4 w = *(const LAS u32x4*)(Qb + ch * 17408 + c * 272 + 16 * p); const float sc = rqs[ch * 64 + c] * 0.08838834764831845f * __expf(gcs[ch * 64 + c]);
        u32x4 o; o.x = pk2(bflo(w.x) * sc, bfhi(w.x) * sc); o.y = pk2(bflo(w.y) * sc, bfhi(w.y) * sc); o.z = pk2(bflo(w.z) * sc, bfhi(w.z) * sc); o.w = pk2(bflo(w.w) * sc, bfhi(w.w) * sc);
        *(GAS u32x4*)((gbf*)(F.ws + WS_SCR + SCR_GQD) + cu * 8192 + c * 128 + 8 * p) = o; }
    for (int task = F.tid; task < 2048; task += NTHR) { const int ch = task >> 10, d = (task >> 3) & 127, o8 = task & 7; const size_t cu = (size_t)bh * 64 + 2 * np + ch;
        const float gl = gcs[ch * 64 + 63]; float v[8];
#pragma unroll
        for (int j = 0; j < 8; ++j) { const int c = 8 * o8 + j; v[j] = bf2f(*(const LAS unsigned short*)(Kb + ch * 17408 + c * 272 + 2 * d)) * rks[ch * 64 + c] * __expf(gl - gcs[ch * 64 + c]); }
        u32x4 o; o.x = pk2(v[0], v[1]); o.y = pk2(v[2], v[3]); o.z = pk2(v[4], v[5]); o.w = pk2(v[6], v[7]);
        *(GAS u32x4*)((gbf*)(F.ws + WS_SCR + SCR_GKDT) + cu * 8192 + d * 64 + 8 * o8) = o; }
    if (F.tid < 2) ((gf32*)(F.ws + WS_SCR + SCR_GDEC))[(size_t)bh * 64 + 2 * np + F.tid] = __expf(gcs[F.tid * 64 + 63]);
    __syncthreads();
}

__device__ __forceinline__ void ssd_dt_acum(Frame& F, int b, int c, int g, const gf32* A_log, const gf32* dt_bias, LAS float* dtl, LAS float* Acl, bool write_cdec) {
    if (F.wave < 6) { const int r = F.wave, hh = 6 * g + r; const size_t m = (size_t)(b * SEQ + 128 * c + 2 * F.lane);
        const gf32* SMALL = (const gf32*)(F.ws + WS_SMALL);
        const float bias = dt_bias[hh], a = -__expf(A_log[hh]);
        const float dt0 = softplus_f(SMALL[m * 32 + 12 + hh] + bias), dt1 = softplus_f(SMALL[(m + 1) * 32 + 12 + hh] + bias);
        const float d0 = a * dt0, d1 = a * dt1; float s = d0 + d1;
#pragma unroll
        for (int o = 1; o < 64; o <<= 1) { const float t = __builtin_bit_cast(float, __builtin_amdgcn_ds_bpermute(((F.lane - o) & 63) << 2, __builtin_bit_cast(int, s))); if (F.lane >= o) s += t; }
        dtl[r * 128 + 2 * F.lane] = dt0; dtl[r * 128 + 2 * F.lane + 1] = dt1; Acl[r * 128 + 2 * F.lane] = s - d1; Acl[r * 128 + 2 * F.lane + 1] = s;
        if (write_cdec && F.lane == 63) ((gf32*)(F.ws + WS_SCR + SCR_CDEC))[(b * 32 + c) * 12 + hh] = __expf(s); }
}
__device__ __forceinline__ void ssd_state_unit(Frame& F, int u, const gf32* convw, const gf32* convb, const gf32* A_log, const gf32* dt_bias) {
    const gbf* PROJ = (const gbf*)(F.ws + WS_PROJ);
    const int b = u >> 6, c = (u >> 1) & 31, g = u & 1;
    LAS float* dtl = (LAS float*)F.lds; LAS float* Acl = dtl + 768;
    LAS unsigned char* BT = F.lds + 6144;
    LAS unsigned char* XsT = F.lds + 40960;
    ssd_dt_acum(F, b, c, g, A_log, dt_bias, dtl, Acl, true);
    __syncthreads();
    gf32* ST = (gf32*)(F.ws + WS_SCR + SCR_ST);
    const int fr = F.lane & 15, fq = F.lane >> 4;
#pragma unroll 1
    for (int half = 0; half < 2; ++half) {
        { const int noct = half == 0 ? 40 : 24;
            if (F.tid < noct * 8) { const int oct = F.tid >> 3, seg = F.tid & 7; const int xo = half == 0 ? oct - 16 : oct;
                const int xc = xo < 0 ? 768 + g * 128 + 8 * oct : (6 * g + 3 * half) * 64 + 8 * xo;
                const int tr = 128 * c + 16 * seg;
                if (xo < 0) { LAS unsigned char* d = BT + (8 * oct) * 272 + (16 * seg) * 2;
                    conv8x16<false>(PROJ + (size_t)(b * SEQ + tr) * NPJ + PC_SXBC + xc, tr > 0, convw + xc, SXBC, convb + xc, [](int) { return 1.0f; },
                                    [&](int k, u32x4 lo, u32x4 hi) { *(LAS u32x4*)(d + k * 272) = lo; *(LAS u32x4*)(d + k * 272 + 16) = hi; });
                } else { const int rr = xo >> 3, r = 3 * half + rr; const float al = Acl[r * 128 + 127]; LAS unsigned char* d = XsT + (8 * xo) * 272 + (16 * seg) * 2;
                    conv8x16<false>(PROJ + (size_t)(b * SEQ + tr) * NPJ + PC_SXBC + xc, tr > 0, convw + xc, SXBC, convb + xc, [&](int i) { return dtl[r * 128 + 16 * seg + i] * __expf(al - Acl[r * 128 + 16 * seg + i]); },
                                    [&](int k, u32x4 lo, u32x4 hi) { *(LAS u32x4*)(d + k * 272) = lo; *(LAS u32x4*)(d + k * 272 + 16) = hi; });
                } } }
        __syncthreads();
        bf16x8 bfm[4];
#pragma unroll
        for (int ks = 0; ks < 4; ++ks) bfm[ks] = ld_frag16(BT + (16 * F.wave + fr) * 272 + (32 * ks + 8 * fq) * 2);
#pragma unroll
        for (int rr = 0; rr < 3; ++rr) { const int hh = 6 * g + 3 * half + rr; gf32* dstp = ST + ((size_t)((b * 32 + c) * 12 + hh)) * 8192;
#pragma unroll
            for (int ph2 = 0; ph2 < 2; ++ph2) { bf16x8 xf[2][4];
#pragma unroll
                for (int p2 = 0; p2 < 2; ++p2)
#pragma unroll
                    for (int ks = 0; ks < 4; ++ks) xf[p2][ks] = ld_frag16(XsT + ((rr * 64 + 16 * (2 * ph2 + p2) + fr) * 272) + (32 * ks + 8 * fq) * 2);
#pragma unroll
                for (int p2 = 0; p2 < 2; ++p2) { const int pt = 2 * ph2 + p2; f32x4 acc = {0.f, 0.f, 0.f, 0.f};
#pragma unroll
                    for (int ks = 0; ks < 4; ++ks) acc = MFMA16(xf[p2][ks], bfm[ks], acc);
#pragma unroll
                    for (int j = 0; j < 4; ++j) dstp[(16 * pt + 4 * fq + j) * 128 + 16 * F.wave + fr] = acc[j]; } } }
        __syncthreads();
    }
}

__device__ __forceinline__ void ssd_scan_phase(Frame& F) {
    const gf32* ST = (const gf32*)(F.ws + WS_SCR + SCR_ST); const gf32* CDEC = (const gf32*)(F.ws + WS_SCR + SCR_CDEC); gbf* PREV = (gbf*)(F.ws + WS_SCR + SCR_PREV);
    for (int i = F.bx * NTHR + F.tid; i < BATCH * SH * 8192 / 2; i += F.G * NTHR) {
        const int e2 = i % 4096, bh = i / 4096, b = bh / 12, hh = bh % 12;
        f32x2 run = {0.f, 0.f};
#pragma unroll 8
        for (int c = 0; c < 32; ++c) { const size_t o = ((size_t)((b * 32 + c) * 12 + hh)) * 8192 + 2 * e2;
            *(GAS unsigned*)(PREV + o) = pk2(run.x, run.y);
            const f32x2 st = *(const GAS f32x2*)(ST + o); const float d = CDEC[(b * 32 + c) * 12 + hh]; run = run * d + st; }
    }
}

__device__ __forceinline__ void ssd_out_unit(Frame& F, int u, const gf32* convw, const gf32* convb, const gf32* A_log, const gf32* dt_bias, const gf32* Dskip) {
    const gbf* PROJ = (const gbf*)(F.ws + WS_PROJ); const gbf* PREV = (const gbf*)(F.ws + WS_SCR + SCR_PREV); gbf* MIX = (gbf*)(F.ws + WS_MIX);
    const int b = u >> 6, c = (u >> 1) & 31, g = u & 1;
    LAS float* dtl = (LAS float*)F.lds; LAS float* Acl = dtl + 768;
    LAS unsigned char* Bm = F.lds + 6144;
    LAS unsigned char* Cm = F.lds + 40960;
    LAS unsigned char* XT = F.lds + 75776;
    ssd_dt_acum(F, b, c, g, A_log, dt_bias, dtl, Acl, false);
    __syncthreads();
    const int fr = F.lane & 15, fq = F.lane >> 4, w = F.wave, lrow = 16 * w + fr, dl = lrow - 4 * fq;
    f32x4 cb[8]; bf16x8 cf[4];
    const size_t m = (size_t)(b * SEQ + 128 * c + lrow);
#pragma unroll 1
    for (int half = 0; half < 2; ++half) {
        { const int noct = half == 0 ? 56 : 24;
            if (F.tid < noct * 8) { const int oct = F.tid >> 3, seg = F.tid & 7; const int xo = half == 0 ? oct - 32 : oct;
                const int xc = xo < 0 ? 768 + (oct >> 4) * 256 + g * 128 + 8 * (oct & 15) : (6 * g + 3 * half) * 64 + 8 * xo;
                const int tr = 128 * c + 16 * seg;
                if (xo < 0) { LAS unsigned char* d = ((oct >> 4) ? Cm : Bm) + (16 * seg) * 272 + 16 * (oct & 15);
                    conv8x16<true>(PROJ + (size_t)(b * SEQ + tr) * NPJ + PC_SXBC + xc, tr > 0, convw + xc, SXBC, convb + xc, [](int) { return 1.0f; },
                                   [&](int i, u32x4 a, u32x4) { *(LAS u32x4*)(d + i * 272) = a; });
                } else { LAS unsigned char* d = XT + (8 * xo) * 272 + (16 * seg) * 2;
                    conv8x16<false>(PROJ + (size_t)(b * SEQ + tr) * NPJ + PC_SXBC + xc, tr > 0, convw + xc, SXBC, convb + xc, [](int) { return 1.0f; },
                                    [&](int k, u32x4 lo, u32x4 hi) { *(LAS u32x4*)(d + k * 272) = lo; *(LAS u32x4*)(d + k * 272 + 16) = hi; });
                } } }
        __syncthreads();
        if (half == 0) {
#pragma unroll
            for (int ks = 0; ks < 4; ++ks) cf[ks] = ld_frag16(Cm + lrow * 272 + (32 * ks + 8 * fq) * 2);
#pragma unroll
            for (int st = 0; st < 8; ++st) { cb[st] = (f32x4){0.f, 0.f, 0.f, 0.f};
                if (st <= w) {
#pragma unroll
                    for (int ks = 0; ks < 4; ++ks) cb[st] = MFMA16(ld_frag16(Bm + (16 * st + fr) * 272 + (32 * ks + 8 * fq) * 2), cf[ks], cb[st]); } }
        }
#pragma unroll 1
        for (int rr = 0; rr < 3; ++rr) { const int r = 3 * half + rr, hh = 6 * g + r;
            const float al = Acl[r * 128 + lrow], el = __expf(al), Dh = Dskip[hh];
            const gbf* pv = PREV + ((size_t)((b * 32 + c) * 12 + hh)) * 8192;
            f32x4 y[4];
#pragma unroll
            for (int ph2 = 0; ph2 < 2; ++ph2) { bf16x8 pf[2][4];
#pragma unroll
                for (int p2 = 0; p2 < 2; ++p2)
#pragma unroll
                    for (int ks = 0; ks < 4; ++ks) pf[p2][ks] = *(const GAS bf16x8*)(pv + (16 * (2 * ph2 + p2) + fr) * 128 + 32 * ks + 8 * fq);
#pragma unroll
                for (int p2 = 0; p2 < 2; ++p2) { f32x4 acc = {0.f, 0.f, 0.f, 0.f};
#pragma unroll
                    for (int ks = 0; ks < 4; ++ks) acc = MFMA16(pf[p2][ks], cf[ks], acc);
                    y[2 * ph2 + p2] = acc * el; } }
#pragma unroll
            for (int sb = 0; sb < 4; ++sb) {
                if (2 * sb <= w) {
                    const int s0 = 32 * sb + 4 * fq, s1 = s0 + 16;
                    const f32x4 a0 = *(const LAS f32x4*)(Acl + r * 128 + s0), a1 = *(const LAS f32x4*)(Acl + r * 128 + s1);
                    const f32x4 d0 = *(const LAS f32x4*)(dtl + r * 128 + s0), d1 = *(const LAS f32x4*)(dtl + r * 128 + s1);
                    f32x4 g0, g1;
#pragma unroll
                    for (int j = 0; j < 4; ++j) { g0[j] = (dl >= 32 * sb + j) ? cb[2 * sb][j] * __expf(al - a0[j]) * d0[j] : 0.f; g1[j] = (dl >= 32 * sb + 16 + j) ? cb[2 * sb + 1][j] * __expf(al - a1[j]) * d1[j] : 0.f; }
                    const bf16x8 gf = pack_frag(g0, g1);
                    { bf16x8 xf[4];
#pragma unroll
                        for (int pt = 0; pt < 4; ++pt) { const LAS unsigned char* xp = XT + (rr * 64 + 16 * pt + fr) * 272; xf[pt] = ld_frag8x2(xp + s0 * 2, xp + s1 * 2); }
#pragma unroll
                        for (int pt = 0; pt < 4; ++pt) y[pt] = MFMA16(xf[pt], gf, y[pt]); }
                }
            }
#pragma unroll
            for (int pt = 0; pt < 4; ++pt) {
                const u32x2 zw = *(const GAS u32x2*)(PROJ + m * NPJ + PC_SZ + hh * 64 + 16 * pt + 4 * fq);
                f32x4 v = y[pt];
#pragma unroll
                for (int j = 0; j < 4; ++j) v[j] += Dh * bf2f(*(const LAS unsigned short*)(XT + (rr * 64 + 16 * pt + 4 * fq + j) * 272 + 2 * lrow));
                v[0] *= silu_f(bflo(zw.x)); v[1] *= silu_f(bfhi(zw.x)); v[2] *= silu_f(bflo(zw.y)); v[3] *= silu_f(bfhi(zw.y));
                u32x2 o; o.x = pk2(v[0], v[1]); o.y = pk2(v[2], v[3]);
                *(GAS u32x2*)(MIX + m * D + 1280 + hh * 64 + 16 * pt + 4 * fq) = o; }
        }
        __syncthreads();
    }
}

__device__ __forceinline__ void gdn_scan(Frame& F, int bh) {
    const int b = bh / 6, h = bh % 6, fr = F.lane & 15, fq = F.lane >> 4, e0 = 16 * F.wave;
    const gbf* GW = (const gbf*)(F.ws + WS_SCR + SCR_GW) + (size_t)bh * 64 * 8192; const gbf* GQD = (const gbf*)(F.ws + WS_SCR + SCR_GQD) + (size_t)bh * 64 * 8192;
    const gbf* GKDT = (const gbf*)(F.ws + WS_SCR + SCR_GKDT) + (size_t)bh * 64 * 8192; const gbf* GUT = (const gbf*)(F.ws + WS_SCR + SCR_GUT) + (size_t)bh * 64 * 8192;
    const gbf* GQK = (const gbf*)(F.ws + WS_SCR + SCR_GQK) + (size_t)bh * 64 * 4096; const gf32* GDEC = (const gf32*)(F.ws + WS_SCR + SCR_GDEC) + bh * 64;
    gbf* MIX = (gbf*)(F.ws + WS_MIX);
    u32x4 preA[7], preB[7]; u32x2 upreA[4], upreB[4];
#define GS_LOAD(pre, upre, n) do { _Pragma("unroll") for (int i = 0; i < 7; ++i) { const int p = F.tid + NTHR * i; \
        const gbf* src = (i < 2) ? GW + (size_t)(n) * 8192 + 8 * p : (i < 4) ? GQD + (size_t)(n) * 8192 + 8 * (p - 1024) : (i < 6) ? GKDT + (size_t)(n) * 8192 + 8 * (p - 2048) : GQK + (size_t)(n) * 4096 + 8 * (p - 3072); \
        pre[i] = *(const GAS u32x4*)src; } \
        _Pragma("unroll") for (int ct = 0; ct < 4; ++ct) upre[ct] = *(const GAS u32x2*)(GUT + (size_t)(n) * 8192 + (e0 + fr) * 64 + 16 * ct + 4 * fq); } while (0)
#define GS_STORE(pre, buf) do { LAS unsigned char* B_ = F.lds + (buf) * 62464; _Pragma("unroll") for (int i = 0; i < 7; ++i) { const int p = F.tid + NTHR * i; \
        const int off = (i < 2) ? (p >> 4) * 272 + (p & 15) * 16 : (i < 4) ? 17408 + ((p - 1024) >> 4) * 272 + (p & 15) * 16 : (i < 6) ? 34816 + ((p - 2048) >> 3) * 144 + (p & 7) * 16 : 53248 + ((p - 3072) >> 3) * 144 + (p & 7) * 16; \
        *(LAS u32x4*)(B_ + off) = pre[i]; } } while (0)
    f32x4 S[8];
#pragma unroll
    for (int dt = 0; dt < 8; ++dt) S[dt] = (f32x4){0.f, 0.f, 0.f, 0.f};
    u32x2 ucur[4];
    auto chunk = [&](const int n, const int buf) __attribute__((always_inline)) {
        const LAS unsigned char* Bf = F.lds + buf * 62464;
        const float dec = GDEC[n];
        bf16x8 Sb[4];
#pragma unroll
        for (int kb = 0; kb < 4; ++kb) Sb[kb] = pack_frag(S[2 * kb], S[2 * kb + 1]);
        f32x4 vn[4], o[4];
#pragma unroll
        for (int cp = 0; cp < 2; ++cp) { bf16x8 wf[2][4], qf[2][4];
#pragma unroll
            for (int c2 = 0; c2 < 2; ++c2) { const LAS unsigned char* wp = Bf + (16 * (2 * cp + c2) + fr) * 272;
#pragma unroll
                for (int kb = 0; kb < 4; ++kb) { const int o0 = (32 * kb + 4 * fq) * 2; wf[c2][kb] = ld_frag8x2(wp + o0, wp + o0 + 32); } }
#pragma unroll
            for (int c2 = 0; c2 < 2; ++c2) { const LAS unsigned char* qp = Bf + 17408 + (16 * (2 * cp + c2) + fr) * 272;
#pragma unroll
                for (int kb = 0; kb < 4; ++kb) { const int o0 = (32 * kb + 4 * fq) * 2; qf[c2][kb] = ld_frag8x2(qp + o0, qp + o0 + 32); } }
#pragma unroll
            for (int c2 = 0; c2 < 2; ++c2) { const int ct = 2 * cp + c2; f32x4 aw = {0.f, 0.f, 0.f, 0.f}, aq = {0.f, 0.f, 0.f, 0.f};
#pragma unroll
                for (int kb = 0; kb < 4; ++kb) { aw = MFMA16(wf[c2][kb], Sb[kb], aw); aq = MFMA16(qf[c2][kb], Sb[kb], aq); }
                vn[ct] = (f32x4){bflo(ucur[ct].x), bfhi(ucur[ct].x), bflo(ucur[ct].y), bfhi(ucur[ct].y)} - aw; o[ct] = aq; } }
        bf16x8 Vf[2];
#pragma unroll
        for (int sb = 0; sb < 2; ++sb) Vf[sb] = pack_frag(vn[2 * sb], vn[2 * sb + 1]);
        { bf16x8 kq[4][2];
#pragma unroll
            for (int ct = 0; ct < 4; ++ct) { const LAS unsigned char* kp = Bf + 53248 + (16 * ct + fr) * 144;
#pragma unroll
                for (int sb = 0; sb < 2; ++sb) { const int o0 = (32 * sb + 4 * fq) * 2; kq[ct][sb] = ld_frag8x2(kp + o0, kp + o0 + 32); } }
#pragma unroll
            for (int ct = 0; ct < 4; ++ct)
#pragma unroll
                for (int sb = 0; sb < 2; ++sb) o[ct] = MFMA16(kq[ct][sb], Vf[sb], o[ct]); }
#pragma unroll
        for (int dh = 0; dh < 2; ++dh) { bf16x8 kd[4][2];
#pragma unroll
            for (int d4 = 0; d4 < 4; ++d4) { const LAS unsigned char* kp = Bf + 34816 + (16 * (4 * dh + d4) + fr) * 144;
#pragma unroll
                for (int cbk = 0; cbk < 2; ++cbk) { const int o0 = (32 * cbk + 4 * fq) * 2; kd[d4][cbk] = ld_frag8x2(kp + o0, kp + o0 + 32); } }
#pragma unroll
            for (int d4 = 0; d4 < 4; ++d4) { f32x4 acc = S[4 * dh + d4] * dec;
#pragma unroll
                for (int cbk = 0; cbk < 2; ++cbk) acc = MFMA16(kd[d4][cbk], Vf[cbk], acc);
                S[4 * dh + d4] = acc; } }
#pragma unroll
        for (int ct = 0; ct < 4; ++ct)
#pragma unroll
            for (int j = 0; j < 4; ++j) MIX[(size_t)(b * SEQ + 64 * n + 16 * ct + 4 * fq + j) * D + 512 + h * 128 + e0 + fr] = f2bf(o[ct][j]);
    };
    GS_LOAD(preA, upreA, 0); GS_STORE(preA, 0);
#pragma unroll
    for (int ct = 0; ct < 4; ++ct) ucur[ct] = upreA[ct];
    GS_LOAD(preB, upreB, 1);
    __syncthreads();
#pragma unroll 1
    for (int n = 0; n < 64; n += 2) {
        if (n + 2 < 64) GS_LOAD(preA, upreA, n + 2);
        chunk(n, 0);
        GS_STORE(preB, 1);
#pragma unroll
        for (int ct = 0; ct < 4; ++ct) ucur[ct] = upreB[ct];
        __syncthreads();
        if (n + 3 < 64) GS_LOAD(preB, upreB, n + 3);
        chunk(n + 1, 1);
        if (n + 2 < 64) { GS_STORE(preA, 0);
#pragma unroll
            for (int ct = 0; ct < 4; ++ct) ucur[ct] = upreA[ct]; }
        __syncthreads();
    }
#undef GS_LOAD
#undef GS_STORE
}

__device__ __forceinline__ void gdn_post_phase(Frame& F, const gf32* ogain) {
    const gbf* PROJ = (const gbf*)(F.ws + WS_PROJ); gbf* MIX = (gbf*)(F.ws + WS_MIX);
    const int sub = F.tid & 15;
    const f32x4 g0 = *(const GAS f32x4*)(ogain + 8 * sub), g1 = *(const GAS f32x4*)(ogain + 8 * sub + 4);
    for (int task = (F.bx * NTHR + F.tid) >> 4; task < M * GH; task += (F.G * NTHR) >> 4) {
        const int m = task / GH, h = task % GH;
        gbf* p = MIX + (size_t)m * D + 512 + h * 128 + 8 * sub;
        const u32x4 w = *(const u32x4*)p; const u32x4 gz = *(const GAS u32x4*)(PROJ + (size_t)m * NPJ + PC_GGATE + h * 128 + 8 * sub);
        float v[8] = {bflo(w.x), bfhi(w.x), bflo(w.y), bfhi(w.y), bflo(w.z), bfhi(w.z), bflo(w.w), bfhi(w.w)};
        float ss = 0.f;
#pragma unroll
        for (int j = 0; j < 8; ++j) ss += v[j] * v[j];
        ss += shfl_xor_l(ss, 1, F.lane); ss += shfl_xor_l(ss, 2, F.lane); ss += shfl_xor_l(ss, 4, F.lane); ss += shfl_xor_l(ss, 8, F.lane);
        const float r = 1.0f / sqrtf(ss * (1.0f / 128.f) + NORM_EPS);
        const float z[8] = {bflo(gz.x), bfhi(gz.x), bflo(gz.y), bfhi(gz.y), bflo(gz.z), bfhi(gz.z), bflo(gz.w), bfhi(gz.w)};
        const float gg[8] = {g0.x, g0.y, g0.z, g0.w, g1.x, g1.y, g1.z, g1.w};
#pragma unroll
        for (int j = 0; j < 8; ++j) v[j] = v[j] * r * gg[j] * silu_f(z[j]);
        u32x4 o; o.x = pk2(v[0], v[1]); o.y = pk2(v[2], v[3]); o.z = pk2(v[4], v[5]); o.w = pk2(v[6], v[7]);
        *(u32x4*)p = o;
    }
}
__device__ __forceinline__ void ssd_post_phase(Frame& F, const gf32* ngain) {
    gbf* MIX = (gbf*)(F.ws + WS_MIX);
    const int sub = F.tid & 15;
    for (int task = (F.bx * NTHR + F.tid) >> 4; task < M * SG; task += (F.G * NTHR) >> 4) {
        const int m = task >> 1, g = task & 1;
        gbf* p = MIX + (size_t)m * D + 1280 + g * 384 + 8 * sub;
        u32x4 w[3]; float ss = 0.f;
#pragma unroll
        for (int i = 0; i < 3; ++i) { w[i] = *(const GAS u32x4*)(p + 128 * i);
#pragma unroll
            for (int k = 0; k < 4; ++k) { const float a = bflo(w[i][k]), e = bfhi(w[i][k]); ss += a * a + e * e; } }
        ss += shfl_xor_l(ss, 1, F.lane); ss += shfl_xor_l(ss, 2, F.lane); ss += shfl_xor_l(ss, 4, F.lane); ss += shfl_xor_l(ss, 8, F.lane);
        const float r = 1.0f / sqrtf(ss * (1.0f / 384.f) + NORM_EPS);
#pragma unroll
        for (int i = 0; i < 3; ++i) { const gf32* gp = ngain + g * 384 + 128 * i + 8 * sub; const f32x4 g0 = *(const GAS f32x4*)gp, g1 = *(const GAS f32x4*)(gp + 4);
            u32x4 o; o.x = pk2(bflo(w[i].x) * r * g0.x, bfhi(w[i].x) * r * g0.y); o.y = pk2(bflo(w[i].y) * r * g0.z, bfhi(w[i].y) * r * g0.w);
            o.z = pk2(bflo(w[i].z) * r * g1.x, bfhi(w[i].z) * r * g1.y); o.w = pk2(bflo(w[i].w) * r * g1.z, bfhi(w[i].w) * r * g1.w);
            *(GAS u32x4*)(p + 128 * i) = o; }
    }
}

__device__ __forceinline__ void attn_unit(Frame& F, int li, int bh, int qb, const gf32* rel_bias, const gf32* lam4, const gf32* sub_gain) {
    const int b = bh >> 2, h = bh & 3, fr = F.lane & 15, fq = F.lane >> 4, q0 = 128 * qb, mp = F.wave >> 2, wq = F.wave & 3, qw = q0 + 32 * wq;
    const gbf* QN = (const gbf*)(F.ws + WS_SCR + SCR_QN); const gbf* KN = (const gbf*)(F.ws + WS_SCR + SCR_KN); const gbf* VT = (const gbf*)(F.ws + WS_SCR + SCR_VT);
    gbf* MIX = (gbf*)(F.ws + WS_MIX);
    LAS unsigned char* Kl = F.lds;
    LAS unsigned char* Vl = F.lds + 34816;
    LAS float* lut = (LAS float*)(F.lds + 71680);
    if (F.tid < 129) { const int n = F.tid; int bk = n;
        if (n >= 16) { bk = 16 + (n >= 19) + (n >= 21) + (n >= 24) + (n >= 27) + (n >= 31) + (n >= 35) + (n >= 40) + (n >= 46) + (n >= 52) + (n >= 59) + (n >= 67) + (n >= 77) + (n >= 87) + (n >= 99) + (n >= 113); }
        lut[n] = (rel_bias[bk * 4 + h] - rel_bias[31 * 4 + h]) * LOG2E; }
    const float lam_init = 0.8f - 0.6f * __expf(-0.3f * (float)li);
    float lam_full;
    { const float a = lam4[F.lane] * lam4[64 + F.lane], c = lam4[128 + F.lane] * lam4[192 + F.lane];
        lam_full = __expf(wave_sum(a, F.lane)) - __expf(wave_sum(c, F.lane)) + lam_init; }
    bf16x8 Qf[2][2];
#pragma unroll
    for (int qt = 0; qt < 2; ++qt)
#pragma unroll
        for (int ks = 0; ks < 2; ++ks) Qf[qt][ks] = *(const GAS bf16x8*)(QN + (size_t)(b * SEQ + qw + 16 * qt + fr) * 512 + h * 128 + mp * 64 + ks * 32 + fq * 8);
    f32x4 O[2][8];
#pragma unroll
    for (int qt = 0; qt < 2; ++qt)
#pragma unroll
        for (int et = 0; et < 8; ++et) O[qt][et] = (f32x4){0.f, 0.f, 0.f, 0.f};
    float mrun[2] = {-1.0e30f, -1.0e30f}, lrun[2] = {0.f, 0.f};
    const int ntiles = (q0 + 128) >> 6;
    u32x4 pkA[2], pvA[2], pkB[2], pvB[2];
    const gbf* Kg = KN + (size_t)(b * SEQ) * 512 + h * 128; const gbf* Vg = VT + (size_t)(bh * 128) * SEQ;
#define AT_LOAD(pk, pv, t) do { _Pragma("unroll") for (int i = 0; i < 2; ++i) { const int p = F.tid + NTHR * i; \
        pk[i] = *(const GAS u32x4*)(Kg + (size_t)(64 * (t) + (p >> 4)) * 512 + 8 * (p & 15)); pv[i] = *(const GAS u32x4*)(Vg + (size_t)(p >> 3) * SEQ + 64 * (t) + 8 * (p & 7)); } } while (0)
#define AT_STORE(pk, pv, buf) do { _Pragma("unroll") for (int i = 0; i < 2; ++i) { const int p = F.tid + NTHR * i; \
        *(LAS u32x4*)(Kl + (buf) * 17408 + (p >> 4) * 272 + (p & 15) * 16) = pk[i]; *(LAS u32x4*)(Vl + (buf) * 18432 + (p >> 3) * 144 + (p & 7) * 16) = pv[i]; } } while (0)
    const int krow = 8 * (fr >> 2) + (fr & 3);
    auto tile = [&](const int t, const int buf) __attribute__((always_inline)) {
        const int k0 = 64 * t;
        if (k0 <= qw + 31) {
            const bool near = (qw - k0 - 63) < 128;
            const LAS unsigned char* Kb_ = Kl + buf * 17408 + mp * 128; const LAS unsigned char* Vb_ = Vl + buf * 18432;
            f32x4 s[2][2][2];
            { bf16x8 kf[4][2];
#pragma unroll
                for (int ga = 0; ga < 4; ++ga) { const LAS unsigned char* kp = Kb_ + (32 * (ga >> 1) + krow + 4 * (ga & 1)) * 272 + fq * 16; kf[ga][0] = ld_frag16(kp); kf[ga][1] = ld_frag16(kp + 64); }
#pragma unroll
                for (int ga = 0; ga < 4; ++ga)
#pragma unroll
                    for (int qt = 0; qt < 2; ++qt) { f32x4 acc = {0.f, 0.f, 0.f, 0.f}; acc = MFMA16(kf[ga][0], Qf[qt][0], acc); acc = MFMA16(kf[ga][1], Qf[qt][1], acc); s[qt][ga >> 1][ga & 1] = acc; } }
            bf16x8 Pf[2][2];
#pragma unroll
            for (int qt = 0; qt < 2; ++qt) {
                if (near) { const int dbase = qw + 16 * qt + fr - k0 - 8 * fq;
#pragma unroll
                    for (int grp = 0; grp < 2; ++grp)
#pragma unroll
                        for (int ab = 0; ab < 2; ++ab)
#pragma unroll
                            for (int j = 0; j < 4; ++j) { const int dist = dbase - (32 * grp + 4 * ab + j); const int di = dist < 0 ? 0 : (dist > 128 ? 128 : dist); const float bv = lut[di];
                                s[qt][grp][ab][j] = dist < 0 ? -INFINITY : s[qt][grp][ab][j] + bv; }
                }
                float mx = fmaxf(fmaxf(fmaxf(s[qt][0][0][0], s[qt][0][0][1]), fmaxf(s[qt][0][0][2], s[qt][0][0][3])), fmaxf(fmaxf(s[qt][0][1][0], s[qt][0][1][1]), fmaxf(s[qt][0][1][2], s[qt][0][1][3])));
                mx = fmaxf(mx, fmaxf(fmaxf(fmaxf(s[qt][1][0][0], s[qt][1][0][1]), fmaxf(s[qt][1][0][2], s[qt][1][0][3])), fmaxf(fmaxf(s[qt][1][1][0], s[qt][1][1][1]), fmaxf(s[qt][1][1][2], s[qt][1][1][3]))));
                mx = fmaxf(mx, shfl_xor_l(mx, 16, F.lane)); mx = fmaxf(mx, shfl_xor_l(mx, 32, F.lane));
                const float mnew = fmaxf(mrun[qt], mx), alpha = fast_exp2(mrun[qt] - mnew); mrun[qt] = mnew;
                float ps = 0.f;
#pragma unroll
                for (int grp = 0; grp < 2; ++grp)
#pragma unroll
                    for (int ab = 0; ab < 2; ++ab)
#pragma unroll
                        for (int j = 0; j < 4; ++j) { const float p = fast_exp2(s[qt][grp][ab][j] - mnew); s[qt][grp][ab][j] = p; ps += p; }
                lrun[qt] = lrun[qt] * alpha + ps;
                Pf[qt][0] = pack_frag(s[qt][0][0], s[qt][0][1]); Pf[qt][1] = pack_frag(s[qt][1][0], s[qt][1][1]);
#pragma unroll
                for (int et = 0; et < 8; ++et) O[qt][et] = O[qt][et] * alpha;
            }
#pragma unroll
            for (int eh = 0; eh < 2; ++eh) { bf16x8 vf[4][2];
#pragma unroll
                for (int e4 = 0; e4 < 4; ++e4) { const LAS unsigned char* vp = Vb_ + (16 * (4 * eh + e4) + fr) * 144 + (8 * fq) * 2; vf[e4][0] = ld_frag16(vp); vf[e4][1] = ld_frag16(vp + 64); }
#pragma unroll
                for (int e4 = 0; e4 < 4; ++e4)
#pragma unroll
                    for (int qt = 0; qt < 2; ++qt) { f32x4 acc = O[qt][4 * eh + e4]; acc = MFMA16(vf[e4][0], Pf[qt][0], acc); acc = MFMA16(vf[e4][1], Pf[qt][1], acc); O[qt][4 * eh + e4] = acc; } }
        }
    };
    AT_LOAD(pkA, pvA, 0); AT_STORE(pkA, pvA, 0); AT_LOAD(pkB, pvB, 1);
    __syncthreads();
#pragma unroll 1
    for (int t = 0; t < ntiles; t += 2) {
        if (t + 2 < ntiles) AT_LOAD(pkA, pvA, t + 2);
        tile(t, 0);
        AT_STORE(pkB, pvB, 1);
        __syncthreads();
        if (t + 3 < ntiles) AT_LOAD(pkB, pvB, t + 3);
        tile(t + 1, 1);
        if (t + 2 < ntiles) AT_STORE(pkA, pvA, 0);
        __syncthreads();
    }
#undef AT_LOAD
#undef AT_STORE
#pragma unroll
    for (int qt = 0; qt < 2; ++qt) { float l = lrun[qt]; l += shfl_xor_l(l, 16, F.lane); l += shfl_xor_l(l, 32, F.lane); const float sc = (mp ? lam_full : 1.0f) / l;
#pragma unroll
        for (int et = 0; et < 8; ++et) O[qt][et] = O[qt][et] * sc; }
    LAS f32x4* X = (LAS f32x4*)F.lds + (wq * 16) * 64 + F.lane;
    if (mp == 1) {
#pragma unroll
        for (int qt = 0; qt < 2; ++qt)
#pragma unroll
            for (int et = 0; et < 8; ++et) X[(qt * 8 + et) * 64] = O[qt][et]; }
    __syncthreads();
    if (mp == 0) {
#pragma unroll
        for (int qt = 0; qt < 2; ++qt) { float ss = 0.f;
#pragma unroll
            for (int et = 0; et < 8; ++et) { const f32x4 v = O[qt][et] - X[(qt * 8 + et) * 64]; O[qt][et] = v; ss += (v[0] * v[0] + v[1] * v[1]) + (v[2] * v[2] + v[3] * v[3]); }
            ss += shfl_xor_l(ss, 16, F.lane); ss += shfl_xor_l(ss, 32, F.lane);
            const float rs = (1.0f / sqrtf(ss * (1.0f / 128.f) + NORM_EPS)) * (1.0f - lam_init);
            gbf* dst = MIX + (size_t)(b * SEQ + qw + 16 * qt + fr) * D + h * 128 + 4 * fq;
#pragma unroll
            for (int et = 0; et < 8; ++et) { const f32x4 gn = *(const GAS f32x4*)(sub_gain + 16 * et + 4 * fq); const f32x4 v = O[qt][et] * rs * gn;
                u32x2 o; o.x = pk2(v[0], v[1]); o.y = pk2(v[2], v[3]); *(GAS u32x2*)(dst + 16 * et) = o; } }
    }
    __syncthreads();
}

__global__ void __launch_bounds__(NTHR, 2) fwd_kernel(Args args) {
    extern __shared__ __attribute__((aligned(16))) unsigned char lds_raw[];
    Frame F;
    F.lds = (LAS unsigned char*)lds_raw;
    F.MISC = (volatile LAS unsigned*)(F.lds + MISC_OFF);
    F.tid = threadIdx.x; F.lane = F.tid & 63; F.wave = __builtin_amdgcn_readfirstlane(F.tid >> 6);
    F.G = gridDim.x; F.bx = blockIdx.x; F.ws = (GAS unsigned char*)args.ws;
    F.ctl = (gu32*)((GAS unsigned char*)args.ws + WS_CTL);
    for (int u = F.tid; u < (LDS_BYTES - LDSCTL_OFF) / 4; u += NTHR) ((LAS unsigned*)(F.lds + LDSCTL_OFF))[u] = 0u;
    __syncthreads();
    const int wave_s = __builtin_amdgcn_readfirstlane(threadIdx.x >> 6);
    XcdBarrier bar = xcd_barrier_post((unsigned*)(F.ctl + CW_BAR), F.MISC + 8);
    const int lo = args.ph_lo, hi = args.ph_hi;
    int ph = 0;
#define RELAUNDER() do { int _wv = wave_s; asm volatile("" : "+s"(_wv)); unsigned _z = 0u; asm volatile("" : "+v"(_z)); int _t = _wv * 64 + (int)__builtin_amdgcn_mbcnt_hi(~0u, __builtin_amdgcn_mbcnt_lo(~0u, _z)); asm volatile("" : "+v"(_t)); \
        F.tid = _t; F.lane = _t & 63; F.wave = _wv; \
        int _g = gridDim.x; asm volatile("" : "+s"(_g)); F.G = _g; int _b = blockIdx.x; asm volatile("" : "+s"(_b)); F.bx = _b; \
        unsigned char* _w = args.ws; asm volatile("" : "+s"(_w)); F.ws = (GAS unsigned char*)_w; } while (0)
#ifndef DUPMASK
#define DUPMASK 0
#endif
#ifndef DUPG
#define DUPG 0
#endif
#define PHASE_BEGIN(id) if (lo <= ph && ph < hi) { RELAUNDER(); int nrep_ = 1; if ((DUPMASK >> (id)) & 1) { nrep_ = 2; asm volatile("" : "+s"(nrep_)); } _Pragma("unroll 1") for (int rep_ = 0; rep_ < nrep_; ++rep_) {
#ifndef DUPBAR
#define DUPBAR 0
#endif
#define PHASE_END   } if (ph + 1 < hi) { XcdBarrier _b2 = bar; asm volatile("" : "+s"(_b2.x), "+s"(_b2.bar)); xcd_barrier(_b2); if (DUPBAR) { asm volatile("" : "+s"(_b2.x), "+s"(_b2.bar)); xcd_barrier(_b2); } } } ++ph;

#define ARGP(k) ({ const Args* _kp = (const Args*)__builtin_amdgcn_kernarg_segment_ptr(); asm volatile("" : "+s"(_kp)); (const gf32*)_kp->in[k]; })
    gf32* const xout = (gf32*)args.out;

    PHASE_BEGIN(0) { p0_prologue(F, args); norm_phase<false, false>(F, ARGP(0), ARGP(2), (gbf*)(F.ws + WS_H), nullptr); } PHASE_END

    int nlayers = 2; asm volatile("" : "+s"(nlayers));
#pragma unroll 1
    for (int li = 0; li < nlayers; ++li) {
        if (li != 0) { PHASE_BEGIN(1) norm_phase<false, false>(F, (const gf32*)xout, ARGP(2) + li * D, (gbf*)(F.ws + WS_H), nullptr); PHASE_END }
        PHASE_BEGIN(2) {
            pg8::Gemm g{(const gbf*)(F.ws + WS_H), (const gbf*)(F.ws + WS_WIN + li * SZ_WIN), D, 0, 0}; pg8::StaticOrder S; S.init(M, NPJ, F.G, F.bx);
            pg8::EpiProj E{(gbf*)(F.ws + WS_PROJ), (gf32*)(F.ws + WS_SMALL)};
            pg8::gemm_phase<pg8::EpiProj, pg8::StaticOrder>(F.lds, g, S, E, F.tid);
        } PHASE_END
        PHASE_BEGIN(3) {
#pragma unroll 1
            for (int u = F.bx; u < 1280; u += F.G) {
                RELAUNDER();
#ifndef DUPA
#define DUPA 0
#endif
                if (u < 256) { attn_prep_unit(F, u, ARGP(4) + li * 64, ARGP(5) + li * 64); if (DUPA & 1) attn_prep_unit(F, u, ARGP(4) + li * 64, ARGP(5) + li * 64); }
                else if (u < 1024) { gdn_prep_unit(F, u - 256, ARGP(8) + li * 4 * 2304, ARGP(9) + li * 6, ARGP(10) + li * 6); if (DUPA & 2) gdn_prep_unit(F, u - 256, ARGP(8) + li * 4 * 2304, ARGP(9) + li * 6, ARGP(10) + li * 6); }
                else { ssd_state_unit(F, u - 1024, ARGP(12) + li * 4 * SXBC, ARGP(13) + li * SXBC, ARGP(14) + li * 12, ARGP(15) + li * 12); if (DUPA & 4) ssd_state_unit(F, u - 1024, ARGP(12) + li * 4 * SXBC, ARGP(13) + li * SXBC, ARGP(14) + li * 12, ARGP(15) + li * 12); }
            }
        } PHASE_END
        PHASE_BEGIN(4) ssd_scan_phase(F); PHASE_END
        PHASE_BEGIN(5) {
#ifndef DUPC
#define DUPC 0
#endif
            if (F.bx < BATCH * GH) { gdn_scan(F, F.bx); if (DUPC & 1) gdn_scan(F, F.bx); }
            LAS int* qslot = (LAS int*)(F.lds + LDSCTL_OFF);
            constexpr unsigned CONV_LIMIT = 96;
            unsigned* const compq = (unsigned*)(F.ctl + CW_QUEUE + 64 * li + 128 * rep_); unsigned* const convq = (unsigned*)(F.ctl + CW_QUEUE + 512 + 128 * rep_); unsigned* const active = (unsigned*)(F.ctl + CW_QUEUE + 576);
#pragma unroll 1
            for (;;) {
                if (F.tid == 0) { int kind = -1, unit = 0;
                    if (li == 0) { const unsigned a = __hip_atomic_fetch_add(active, 1u, __ATOMIC_RELAXED, __HIP_MEMORY_SCOPE_AGENT);
                        if (a < CONV_LIMIT) { const unsigned c = __hip_atomic_fetch_add(convq, 1u, __ATOMIC_RELAXED, __HIP_MEMORY_SCOPE_AGENT); if (c < (unsigned)N_DEF_UNITS) { kind = 1; unit = (int)c; } }
                        if (kind < 0) __hip_atomic_fetch_sub(active, 1u, __ATOMIC_RELAXED, __HIP_MEMORY_SCOPE_AGENT); }
                    if (kind < 0) { const unsigned q = __hip_atomic_fetch_add(compq, 1u, __ATOMIC_RELAXED, __HIP_MEMORY_SCOPE_AGENT); if (q < 768u) { kind = 0; unit = (int)q; } }
                    if (kind < 0 && li == 0) { const unsigned c = __hip_atomic_fetch_add(convq, 1u, __ATOMIC_RELAXED, __HIP_MEMORY_SCOPE_AGENT); if (c < (unsigned)N_DEF_UNITS) { kind = 2; unit = (int)c; } }
                    qslot[0] = kind; qslot[1] = unit; }
                __syncthreads();
                const int kind = qslot[0], qi = qslot[1];
                __syncthreads();
                if (kind < 0) break;
                RELAUNDER();
                if (kind > 0) { LAS float* scr = (LAS float*)(F.lds) + F.wave * (64 * 65);
                    const CvSrc src{ARGP(3), ARGP(18), ARGP(20), ARGP(21), ARGP(22), ARGP(24), ARGP(25), ARGP(26)};
                    cv_run(F, qi * 64 + 2 * F.wave, 16, 4, [](int d) { return def_item(d); }, src, scr);
                    __syncthreads();
                    if (kind == 1 && F.tid == 0) __hip_atomic_fetch_sub(active, 1u, __ATOMIC_RELAXED, __HIP_MEMORY_SCOPE_AGENT);
                    continue; }
                const int au = qi < 304 ? qi : (qi >= 560 ? qi - 256 : -1);
                if (au >= 0) attn_unit(F, li, au & 15, 31 - (au >> 4), ARGP(1), ARGP(6) + li * 256, ARGP(7) + li * 128);
                else ssd_out_unit(F, qi - 304, ARGP(12) + li * 4 * SXBC, ARGP(13) + li * SXBC, ARGP(14) + li * 12, ARGP(15) + li * 12, ARGP(16) + li * 12);
            }
        } PHASE_END
        PHASE_BEGIN(6) { gdn_post_phase(F, ARGP(11) + li * 128); ssd_post_phase(F, ARGP(17) + li * SW); } PHASE_END
        PHASE_BEGIN(7) { const gf32* xin = (li == 0) ? ARGP(0) : (const gf32*)xout;
            pg8::Gemm g{(const gbf*)(F.ws + WS_MIX), (const gbf*)(F.ws + WS_WOUT + li * SZ_WOUT), D, 0, 0}; pg8::StaticOrder S; S.init(M, D, F.G, F.bx);
            pg8::EpiResF32 E{xin, xout, D};
            pg8::gemm_phase<pg8::EpiResF32, pg8::StaticOrder>(F.lds, g, S, E, F.tid);
        } PHASE_END
        PHASE_BEGIN(8) {
            if (li == 0) norm_phase<false, DENSE_GU_F8 != 0>(F, xout, ARGP(19) + li * D, (gbf*)(F.ws + WS_H), nullptr);
            else norm_phase<true, true>(F, xout, ARGP(19) + li * D, (gbf*)(F.ws + WS_H), ARGP(23));
        } PHASE_END
        PHASE_BEGIN(9) {
            if (li == 0) { if (F.bx == 0 && F.tid < 64) { gi32* tab = (gi32*)(F.ws + WS_ROUTE + RT_TABD); const int z = F.tid >> 9; if (F.tid == 0) tab[0] = 64 + z;
                tab[4 + 4 * F.tid] = z; tab[5 + 4 * F.tid] = 256 * F.tid; tab[6 + 4 * F.tid] = 256 + z; tab[7 + 4 * F.tid] = z; } }
            else route_phase(F);
        } PHASE_END
        PHASE_BEGIN(10) {
            if (li == 0) {
                pg8::Gemm g{(const gbf*)(F.ws + WS_H), (const gbf*)(F.ws + WS_WGU), D, SC_ONE, SC_W8};
                pg8::MoeOrder S{(const gi32*)(F.ws + WS_ROUTE + RT_TABD), 2 * DFF / 256, F.G, F.bx, 2 * DFF};
                pg8::EpiSwiglu<DENSE_DN_F8 != 0> E{(gbf*)(F.ws + WS_ACT), (const gf32*)nullptr};
                int nr2 = 1; if (DUPG & 4) { nr2 = 2; asm volatile("" : "+s"(nr2)); }
#pragma unroll 1
                for (int r2 = 0; r2 < nr2; ++r2)
                pg8::gemm_phase<pg8::EpiSwiglu<DENSE_DN_F8 != 0>, pg8::MoeOrder, DENSE_GU_F8 != 0>(F.lds, g, S, E, F.tid);
            } else {
                pg8::Gemm g{(const gbf*)(F.ws + WS_HG), (const gbf*)(F.ws + WS_MGU), D, SC_ONE, SC_W8};
                pg8::MoeOrder S{(const gi32*)(F.ws + WS_ROUTE + RT_TAB), 2 * DFF / 256, F.G, F.bx, 2 * DFF};
                pg8::EpiSwiglu<true> E{(gbf*)(F.ws + WS_ACTM), (const gf32*)(F.ws + WS_ROUTE + RT_SW)};
                int nr2 = 1; if (DUPG & 1) { nr2 = 2; asm volatile("" : "+s"(nr2)); }
#pragma unroll 1
                for (int r2 = 0; r2 < nr2; ++r2)
                pg8::gemm_phase<pg8::EpiSwiglu<true>, pg8::MoeOrder, true>(F.lds, g, S, E, F.tid);
            }
        } PHASE_END
        PHASE_BEGIN(11) {
            if (li == 0) {
                pg8::Gemm g{(const gbf*)(F.ws + WS_ACT), (const gbf*)(F.ws + WS_WDN), DFF, SC_ACT8, SC_W8};
                pg8::MoeOrder S{(const gi32*)(F.ws + WS_ROUTE + RT_TABD), D / 256, F.G, F.bx, D};
                pg8::EpiDown E{xout, (gbf*)nullptr};
                pg8::gemm_phase<pg8::EpiDown, pg8::MoeOrder, DENSE_DN_F8 != 0>(F.lds, g, S, E, F.tid);
            } else {
                pg8::Gemm g{(const gbf*)(F.ws + WS_ACTM), (const gbf*)(F.ws + WS_MDN), DFF, SC_ACT8, SC_W8};
                pg8::MoeOrder S{(const gi32*)(F.ws + WS_ROUTE + RT_TAB), D / 256, F.G, F.bx, D};
                pg8::EpiDown E{xout, (gbf*)(F.ws + WS_HG)};
                int nr2 = 1; if (DUPG & 2) { nr2 = 2; asm volatile("" : "+s"(nr2)); }
#pragma unroll 1
                for (int r2 = 0; r2 < nr2; ++r2)
                pg8::gemm_phase<pg8::EpiDown, pg8::MoeOrder, true>(F.lds, g, S, E, F.tid);
            }
        } PHASE_END
    }
    PHASE_BEGIN(12) {
        const gi32* tpos = (const gi32*)(F.ws + WS_ROUTE + RT_TPOS); const gbf* Y = (const gbf*)(F.ws + WS_HG);
        const int stride = F.G * NTHR;
#pragma unroll 1
        for (int i0 = F.bx * NTHR + F.tid; i0 < M * (D / 8); i0 += 4 * stride) {
            int p1[4], p2[4]; u32x4 ya[4], yb[4]; f32x4 o0[4], o1[4];
#pragma unroll
            for (int u = 0; u < 4; ++u) { const int i = i0 + u * stride; const int t = (i < M * (D / 8)) ? (i >> 8) : 0; p1[u] = tpos[2 * t]; p2[u] = tpos[2 * t + 1]; }
#pragma unroll
            for (int u = 0; u < 4; ++u) { const int i = i0 + u * stride; const int ii = (i < M * (D / 8)) ? i : 0; const int t = ii >> 8, c8 = ii & 255;
                ya[u] = *(const GAS u32x4*)(Y + (size_t)p1[u] * D + 8 * c8); yb[u] = *(const GAS u32x4*)(Y + (size_t)p2[u] * D + 8 * c8);
                const gf32* o = xout + (size_t)t * D + 8 * c8; o0[u] = *(const GAS f32x4*)o; o1[u] = *(const GAS f32x4*)(o + 4); }
#pragma unroll
            for (int u = 0; u < 4; ++u) { const int i = i0 + u * stride; if (i < M * (D / 8)) { const int t = i >> 8, c8 = i & 255; const u32x4 a = ya[u], b = yb[u]; f32x4 q0 = o0[u], q1 = o1[u];
                q0.x += bflo(a.x) + bflo(b.x); q0.y += bfhi(a.x) + bfhi(b.x); q0.z += bflo(a.y) + bflo(b.y); q0.w += bfhi(a.y) + bfhi(b.y);
                q1.x += bflo(a.z) + bflo(b.z); q1.y += bfhi(a.z) + bfhi(b.z); q1.z += bflo(a.w) + bflo(b.w); q1.w += bfhi(a.w) + bfhi(b.w);
                gf32* o = xout + (size_t)t * D + 8 * c8; *(GAS f32x4*)o = q0; *(GAS f32x4*)(o + 4) = q1; } }
        }
    } PHASE_END
#undef ARGP
#undef RELAUNDER
#undef PHASE_BEGIN
#undef PHASE_END
}

#ifndef N_LAUNCHES
#define N_LAUNCHES 1
#endif
extern "C" void kernel_launch(void* const* d_in, const int* in_sizes, int n_in, void* d_out, int out_size, void* d_ws, size_t ws_size, hipStream_t stream) {
    static int grid = 0;
    if (grid == 0) {
        if (n_in != 27 || out_size != M * D || ws_size < WS_NEED) { fprintf(stderr, "kernel_launch: unexpected shapes: n_in %d out %d ws %zu (need %zu)\n", n_in, out_size, ws_size, (size_t)WS_END_MOE); grid = -1; return; }
        int dev = 0, cus = 0, per_cu = 0;
        if (hipGetDevice(&dev) != hipSuccess || hipDeviceGetAttribute(&cus, hipDeviceAttributeMultiprocessorCount, dev) != hipSuccess) { grid = -1; return; }
        if (hipFuncSetAttribute((const void*)fwd_kernel, hipFuncAttributeMaxDynamicSharedMemorySize, LDS_BYTES) != hipSuccess) { fprintf(stderr, "kernel_launch: hipFuncSetAttribute failed\n"); grid = -1; return; }
        if (hipOccupancyMaxActiveBlocksPerMultiprocessor(&per_cu, (const void*)fwd_kernel, NTHR, LDS_BYTES) != hipSuccess || per_cu < 1) { fprintf(stderr, "kernel_launch: occupancy query says %d\n", per_cu); }
        (void)hipGetLastError();
        grid = cus;
    }
    if (grid < 0) return;
    (void)hipMemsetAsync((char*)d_ws + WS_CTL, 0, CTL_ZERO_BYTES, stream);
    Args a{};
    for (int i = 0; i < 27; ++i) a.in[i] = (const float*)d_in[i];
    a.out = (float*)d_out; a.ws = (unsigned char*)d_ws;
    constexpr int NPH = 23;
#if N_LAUNCHES == 1
    a.ph_lo = 0; a.ph_hi = NPH;
    hipLaunchKernelGGL(fwd_kernel, dim3(grid), dim3(NTHR), LDS_BYTES, stream, a);
#else
    for (int p = 0; p < 24; ++p) { a.ph_lo = p; a.ph_hi = p + 1; hipLaunchKernelGGL(fwd_kernel, dim3(grid), dim3(NTHR), LDS_BYTES, stream, a); }
#endif
}
```
